# Optimizing an MI355X kernel written in HIP

```python
import math
import jax, jax.numpy as jnp
from jax import lax
import numpy as np

D_MODEL = 1024
BATCH = 8
SEQ = 4096
DEPTH = 4

GRID_W = 64
CTX_LEN = 256
HEAD_DIM = 64
N_Q_HEADS = 8
N_KV_HEADS = 2
Q_PER_KV = N_Q_HEADS // N_KV_HEADS
D_ATTN = N_Q_HEADS * HEAD_DIM
D_KV = N_KV_HEADS * HEAD_DIM
WINDOW = 128
BLOCK = 128
ROPE_THETA = 10000.0
D_SSM = D_MODEL // 2
SSM_GROUP = 16
N_SSM_GROUPS = D_SSM // SSM_GROUP
SSM_STATE = 64
D_IN = D_ATTN + 2 * D_KV + D_SSM + 2 * D_MODEL
D_FF = 2816
N_EXPERTS = 8
TOP_K = 2
D_FF_EXPERT = 3584
N_DENSE = (DEPTH + 1) // 2
N_MOE = DEPTH // 2
RMS_EPS = 1e-6
NEG_INF = -1e30

kernel_name = 'hybrid_dit_window_gqa_s5_moe'


def _rmsnorm(x, g):
    xf = x.astype(jnp.float32)
    y = xf * lax.rsqrt(jnp.mean(xf * xf, axis=-1, keepdims=True) + RMS_EPS)
    return (y * g.astype(jnp.float32)).astype(x.dtype)


def _modulate(h, shift, scale):
    return h * (1.0 + scale) + shift


def _split_proj(p):
    sizes = (D_ATTN, D_KV, D_KV, D_SSM, D_MODEL, D_MODEL)
    idx = [sum(sizes[:i + 1]) for i in range(len(sizes) - 1)]
    return jnp.split(p, idx, axis=-1)


def _heads(t, n):
    return t.reshape(t.shape[:2] + (n, HEAD_DIM))


def _axial_rope(L):
    rows = L // GRID_W
    row = jnp.broadcast_to(jnp.arange(rows, dtype=jnp.float32)[:, None], (rows, GRID_W)).reshape(L)
    col = jnp.broadcast_to(jnp.arange(GRID_W, dtype=jnp.float32)[None, :], (rows, GRID_W)).reshape(L)
    n_freq = HEAD_DIM // 4
    inv_freq = ROPE_THETA ** (-jnp.arange(n_freq, dtype=jnp.float32) / n_freq)
    ang = jnp.concatenate([row[:, None] * inv_freq, col[:, None] * inv_freq], axis=-1)
    return jnp.cos(ang), jnp.sin(ang)


def _rope(x, cos, sin):
    half = HEAD_DIM // 2
    x1, x2 = x[..., :half], x[..., half:]
    cs = cos[:, None, :].astype(x.dtype)
    sn = sin[:, None, :].astype(x.dtype)
    return jnp.concatenate([x1 * cs - x2 * sn, x2 * cs + x1 * sn], axis=-1)


def _latent_window_attention(q, k, v, kc, vc, sink):
    Bn, L = q.shape[:2]
    C = kc.shape[1]
    nb = L // BLOCK
    scale = HEAD_DIM ** -0.5
    qb = q.reshape(Bn, nb, BLOCK, N_KV_HEADS, Q_PER_KV, HEAD_DIM)
    pad = ((0, 0), (BLOCK, BLOCK), (0, 0), (0, 0))
    kp = jnp.pad(k, pad).reshape(Bn, nb + 2, BLOCK, N_KV_HEADS, HEAD_DIM)
    vp = jnp.pad(v, pad).reshape(Bn, nb + 2, BLOCK, N_KV_HEADS, HEAD_DIM)
    kb = jnp.concatenate([kp[:, :-2], kp[:, 1:-1], kp[:, 2:]], axis=2)
    vb = jnp.concatenate([vp[:, :-2], vp[:, 1:-1], vp[:, 2:]], axis=2)
    qpos = jnp.arange(nb)[:, None, None] * BLOCK + jnp.arange(BLOCK)[None, :, None]
    kpos = jnp.arange(nb)[:, None, None] * BLOCK - BLOCK + jnp.arange(3 * BLOCK)[None, None, :]
    valid = (jnp.abs(qpos - kpos) <= WINDOW) & (kpos >= 0) & (kpos < L)
    s_loc = jnp.einsum('bnqhgd,bnkhd->bnhgqk', qb, kb, preferred_element_type=jnp.float32) * scale
    s_loc = jnp.where(valid[:, None, None], s_loc, NEG_INF)
    s_ctx = jnp.einsum('bnqhgd,bchd->bnhgqc', qb, kc, preferred_element_type=jnp.float32) * scale
    s_sink = jnp.broadcast_to(sink.astype(jnp.float32).reshape(N_KV_HEADS, Q_PER_KV, 1, 1),
                              s_loc.shape[:-1] + (1,))
    p = jax.nn.softmax(jnp.concatenate([s_loc, s_ctx, s_sink], axis=-1), axis=-1)
    p_loc = p[..., :3 * BLOCK].astype(v.dtype)
    p_ctx = p[..., 3 * BLOCK:3 * BLOCK + C].astype(v.dtype)
    o = (jnp.einsum('bnhgqk,bnkhd->bnqhgd', p_loc, vb)
         + jnp.einsum('bnhgqc,bchd->bnqhgd', p_ctx, vc))
    return o.reshape(Bn, L, D_ATTN)


def _context_attention(q, k, v, sink):
    Bn, C = q.shape[:2]
    scale = HEAD_DIM ** -0.5
    qg = q.reshape(Bn, C, N_KV_HEADS, Q_PER_KV, HEAD_DIM)
    s = jnp.einsum('bqhgd,bkhd->bhgqk', qg, k, preferred_element_type=jnp.float32) * scale
    s_sink = jnp.broadcast_to(sink.astype(jnp.float32).reshape(N_KV_HEADS, Q_PER_KV, 1, 1),
                              s.shape[:-1] + (1,))
    p = jax.nn.softmax(jnp.concatenate([s, s_sink], axis=-1), axis=-1)[..., :C]
    o = jnp.einsum('bhgqk,bkhd->bqhgd', p.astype(v.dtype), v)
    return o.reshape(Bn, C, D_ATTN)


def _zoh(a_re, a_im, log_dt, b_re, b_im):
    a = lax.complex(a_re.astype(jnp.float32), a_im.astype(jnp.float32))
    dt = jnp.exp(log_dt.astype(jnp.float32))[..., None]
    a_bar = jnp.exp(a * dt)
    b = lax.complex(b_re.astype(jnp.float32), b_im.astype(jnp.float32))
    b_bar = ((a_bar - 1.0) / a)[..., None] * b
    return a_bar, b_bar


def _scan_combine(e1, e2):
    return (e1[0] * e2[0], e2[0] * e1[1] + e2[1])


def _diag_scan(u, a_bar, b_bar, s0, reverse):
    L = u.shape[1]
    bu = jnp.einsum('blgh,gph->blgp', u.astype(jnp.complex64), b_bar)
    a = jnp.broadcast_to(a_bar, (1, L) + a_bar.shape)
    a_cum, s = lax.associative_scan(_scan_combine, (a, bu), reverse=reverse, axis=1)
    if s0 is not None:
        s = s + a_cum * s0[:, None]
    return s


def _readout(s, c_mat):
    return jnp.einsum('blgp,ghp->blgh', s, c_mat).real


def _bidir_ssm(u_lat, u_ctx, a_bar, b_bar, c_mat, d_skip, need_ctx_out):
    Bn, L, _ = u_lat.shape
    C = u_ctx.shape[1]
    ul = u_lat.astype(jnp.float32).reshape(Bn, L, N_SSM_GROUPS, SSM_GROUP)
    uc = u_ctx.astype(jnp.float32).reshape(Bn, C, N_SSM_GROUPS, SSM_GROUP)
    d = d_skip.astype(jnp.float32)
    sc_f = _diag_scan(uc, a_bar[0], b_bar[0], None, False)
    sc_b = _diag_scan(uc, a_bar[1], b_bar[1], None, True)
    sl_f = _diag_scan(ul, a_bar[0], b_bar[0], sc_f[:, -1], False)
    sl_b = _diag_scan(ul, a_bar[1], b_bar[1], sc_b[:, 0], True)
    y_lat = ((_readout(sl_f, c_mat[0]) + _readout(sl_b, c_mat[1])).reshape(Bn, L, D_SSM)
             + d * u_lat.astype(jnp.float32))
    y_ctx = None
    if need_ctx_out:
        y_ctx = ((_readout(sc_f, c_mat[0]) + _readout(sc_b, c_mat[1])).reshape(Bn, C, D_SSM)
                 + d * u_ctx.astype(jnp.float32))
        y_ctx = y_ctx.astype(u_ctx.dtype)
    return y_lat.astype(u_lat.dtype), y_ctx


def _glu(y, w, b):
    g = jax.nn.gelu(y)
    return g * jax.nn.sigmoid(g @ w + b)


def _merge(o_attn, y_ssm, g_attn, g_ssm, w_pa, w_pb, w_o):
    m = jax.nn.sigmoid(g_attn) * (o_attn @ w_pa) + jax.nn.sigmoid(g_ssm) * (y_ssm @ w_pb)
    return m @ w_o


def _swiglu(h, wg, wu, wd):
    return (jax.nn.silu(h @ wg) * (h @ wu)) @ wd


def _moe_swiglu(h, w_router, b_router, wg, wu, wd):
    shp = h.shape
    hf = h.reshape(-1, shp[-1])
    logits = (hf @ w_router).astype(jnp.float32) + b_router.astype(jnp.float32)
    top_v, top_i = lax.top_k(logits, TOP_K)
    top_w = jax.nn.softmax(top_v, axis=-1)
    gates = jnp.sum(jax.nn.one_hot(top_i, N_EXPERTS, dtype=jnp.float32) * top_w[..., None], axis=-2)
    gates = gates.astype(h.dtype)
    y = jnp.zeros_like(hf)
    for e in range(N_EXPERTS):
        y = y + gates[:, e:e + 1] * _swiglu(hf, wg[e], wu[e], wd[e])
    return y.reshape(shp)


def setup_inputs(seed: int = 0) -> dict:
    key = jax.random.key(seed)
    ks = iter(jax.random.split(key, 40))
    f32 = jnp.float32

    def nrm(shape, s):
        return s * jax.random.normal(next(ks), shape, f32)

    D = D_MODEL
    G, P, H = N_SSM_GROUPS, SSM_STATE, SSM_GROUP
    n_idx = jnp.arange(P, dtype=f32)
    return {
        'x': nrm((BATCH, SEQ, D), 1.0),
        'c': nrm((BATCH, D), 1.0),
        'ctx': nrm((BATCH, CTX_LEN, D), 1.0),
        'c_ctx': nrm((D,), 1.0),
        'w_mod': nrm((DEPTH, D, 6 * D), 0.5 * D ** -0.5),
        'b_mod': nrm((DEPTH, 6 * D), 0.02),
        'norm_g': 1.0 + nrm((DEPTH, 4, D), 0.02),
        'w_in': nrm((DEPTH, D, D_IN), D ** -0.5),
        'attn_sink': nrm((DEPTH, N_Q_HEADS), 0.5),
        'ssm_a_re': -0.5 + nrm((DEPTH, 2, G, P), 0.01),
        'ssm_a_im': math.pi * n_idx + nrm((DEPTH, 2, G, P), 0.01),
        'ssm_log_dt': jax.random.uniform(next(ks), (DEPTH, 2, G), f32, math.log(1e-3), math.log(1e-1)),
        'ssm_b_re': nrm((DEPTH, 2, G, P, H), (2.0 * H) ** -0.5),
        'ssm_b_im': nrm((DEPTH, 2, G, P, H), (2.0 * H) ** -0.5),
        'ssm_c_re': nrm((DEPTH, 2, G, H, P), (2.0 * P) ** -0.5),
        'ssm_c_im': nrm((DEPTH, 2, G, H, P), (2.0 * P) ** -0.5),
        'ssm_d': nrm((DEPTH, D_SSM), 1.0),
        'w_glu': nrm((DEPTH, D_SSM, D_SSM), D_SSM ** -0.5),
        'b_glu': nrm((DEPTH, D_SSM), 0.02),
        'w_branch_attn': nrm((DEPTH, D_ATTN, D), D_ATTN ** -0.5),
        'w_branch_ssm': nrm((DEPTH, D_SSM, D), D_SSM ** -0.5),
        'w_out': nrm((DEPTH, D, D), D ** -0.5),
        'w_ffn_gate': nrm((N_DENSE, D, D_FF), D ** -0.5),
        'w_ffn_up': nrm((N_DENSE, D, D_FF), D ** -0.5),
        'w_ffn_down': nrm((N_DENSE, D_FF, D), D_FF ** -0.5),
        'w_router': nrm((N_MOE, D, N_EXPERTS), D ** -0.5),
        'b_router': nrm((N_MOE, N_EXPERTS), 0.01),
        'w_exp_gate': nrm((N_MOE, N_EXPERTS, D, D_FF_EXPERT), D ** -0.5),
        'w_exp_up': nrm((N_MOE, N_EXPERTS, D, D_FF_EXPERT), D ** -0.5),
        'w_exp_down': nrm((N_MOE, N_EXPERTS, D_FF_EXPERT, D), D_FF_EXPERT ** -0.5),
    }


def reference(x, c, ctx, c_ctx, w_mod, b_mod, norm_g, w_in, attn_sink, ssm_a_re, ssm_a_im,
              ssm_log_dt, ssm_b_re, ssm_b_im, ssm_c_re, ssm_c_im, ssm_d, w_glu, b_glu,
              w_branch_attn, w_branch_ssm, w_out, w_ffn_gate, w_ffn_up, w_ffn_down,
              w_router, b_router, w_exp_gate, w_exp_up, w_exp_down):
    L = x.shape[1]
    cos, sin = _axial_rope(L)
    xc = ctx
    cond_lat = jax.nn.silu(c)
    cond_ctx = jax.nn.silu(c_ctx)
    for l in range(DEPTH):
        last = l == DEPTH - 1
        mod_l = jnp.split((cond_lat @ w_mod[l] + b_mod[l])[:, None, :], 6, axis=-1)
        mod_c = jnp.split(cond_ctx @ w_mod[l] + b_mod[l], 6, axis=-1)

        h_l = _modulate(_rmsnorm(x, norm_g[l, 0]), mod_l[0], mod_l[1])
        h_c = _modulate(_rmsnorm(xc, norm_g[l, 0]), mod_c[0], mod_c[1])
        q_l, k_l, v_l, u_l, ga_l, gb_l = _split_proj(h_l @ w_in[l])
        q_c, k_c, v_c, u_c, ga_c, gb_c = _split_proj(h_c @ w_in[l])
        k_c = _heads(k_c, N_KV_HEADS)
        v_c = _heads(v_c, N_KV_HEADS)

        q_lh = _rope(_heads(q_l, N_Q_HEADS), cos, sin)
        k_lh = _rope(_heads(k_l, N_KV_HEADS), cos, sin)
        o_l = _latent_window_attention(q_lh, k_lh, _heads(v_l, N_KV_HEADS), k_c, v_c, attn_sink[l])

        a_bar, b_bar = _zoh(ssm_a_re[l], ssm_a_im[l], ssm_log_dt[l], ssm_b_re[l], ssm_b_im[l])
        c_mat = lax.complex(ssm_c_re[l].astype(jnp.float32), ssm_c_im[l].astype(jnp.float32))
        y_l, y_c = _bidir_ssm(u_l, u_c, a_bar, b_bar, c_mat, ssm_d[l], not last)
        s_l = _glu(y_l, w_glu[l], b_glu[l])

        m_l = _merge(o_l, s_l, ga_l, gb_l, w_branch_attn[l], w_branch_ssm[l], w_out[l])
        x = x + mod_l[2] * _rmsnorm(m_l, norm_g[l, 1])
        if not last:
            o_c = _context_attention(_heads(q_c, N_Q_HEADS), k_c, v_c, attn_sink[l])
            s_c = _glu(y_c, w_glu[l], b_glu[l])
            m_c = _merge(o_c, s_c, ga_c, gb_c, w_branch_attn[l], w_branch_ssm[l], w_out[l])
            xc = xc + mod_c[2] * _rmsnorm(m_c, norm_g[l, 1])

        j = l // 2
        if l % 2 == 0:
            ffn = lambda h: _swiglu(h, w_ffn_gate[j], w_ffn_up[j], w_ffn_down[j])
        else:
            ffn = lambda h: _moe_swiglu(h, w_router[j], b_router[j], w_exp_gate[j], w_exp_up[j], w_exp_down[j])
        h_l = _modulate(_rmsnorm(x, norm_g[l, 2]), mod_l[3], mod_l[4])
        x = x + mod_l[5] * _rmsnorm(ffn(h_l), norm_g[l, 3])
        if not last:
            h_c = _modulate(_rmsnorm(xc, norm_g[l, 2]), mod_c[3], mod_c[4])
            xc = xc + mod_c[5] * _rmsnorm(ffn(h_c), norm_g[l, 3])
    return x
```

```cpp
#include <hip/hip_runtime.h>
#include <cstdio>
#include <cstdint>

#ifndef SKIPMASK
#define SKIPMASK 0ull
#endif
#define PH(id) if (!((SKIPMASK >> (id)) & 1ull))
#ifndef F8MASK
#define F8MASK 0xEu
#endif
#ifndef REPMASK
#define REPMASK 0ull
#endif
#define NREP(id) ((((REPMASK) >> (id)) & 1ull) ? 2 : 1)
#define RPT(id) for (int rep_ = 0; rep_ < NREP(id); ++rep_)
#define GAS __attribute__((address_space(1)))
#define LAS __attribute__((address_space(3)))
typedef unsigned short bf16;
typedef short bf16x8 __attribute__((ext_vector_type(8)));
typedef short s16x4 __attribute__((ext_vector_type(4)));
typedef float f32x2 __attribute__((ext_vector_type(2)));
typedef float f32x4 __attribute__((ext_vector_type(4)));
typedef float f32x16 __attribute__((ext_vector_type(16)));
typedef unsigned u32x2 __attribute__((ext_vector_type(2)));
typedef unsigned u32x4 __attribute__((ext_vector_type(4)));
typedef __bf16 bf16x2_t __attribute__((ext_vector_type(2)));
typedef GAS unsigned gu32;

constexpr int D = 1024, NB = 8, SEQ = 4096, CTXL = 256, DEPTH = 4;
constexpr int TL = NB * SEQ, TCX = NB * CTXL, TT = TL + TCX;
constexpr int DIN = 3328, DATT = 512, DKV = 128, DSSM = 512, DFF = 2816, DFFE = 3584, NEXP = 8;
constexpr int NG = 32, NST = 64, NH = 16, TCH = 32, NCHUNK = 136, SSM_ROWS = NB * NCHUNK, SSM_RPAD = 1280, AG_PITCH = 768;
constexpr float RMS_EPS = 1e-6f;
constexpr float LOG2E = 1.4426950408889634f;
constexpr float QSCALE = 0.125f * LOG2E;
constexpr int MOE_MAXTILES = 280, MOE_PASS_TILES = 140;
constexpr int NQKVU = 1280, NGATE = 2048;
constexpr size_t WIN_L = (size_t)NQKVU * D * 2 + (size_t)NGATE * D;

constexpr size_t al4k(size_t x) { return (x + 4095) & ~(size_t)4095; }
constexpr size_t WS_CTL = 0, CTL_ZERO_BYTES = 1u << 20;
constexpr size_t WS_ZERO = 524288;
constexpr size_t WS_MOD = CTL_ZERO_BYTES;
constexpr size_t WS_MODP = WS_MOD + al4k((size_t)4 * 9 * 6144 * 4);
constexpr size_t WS_ROPE = WS_MODP + al4k((size_t)16 * 4 * 9 * 6144 * 4);
constexpr size_t WS_POW = WS_ROPE + al4k((size_t)2 * 4096 * 32 * 4);
constexpr size_t WS_BBAR = WS_POW + al4k((size_t)4 * 2 * 32 * 64 * 33 * 8);
constexpr size_t WS_KFULL = WS_BBAR + al4k((size_t)4 * 2 * 32 * 64 * 16 * 8);
constexpr size_t WS_TOKREC = WS_KFULL + al4k((size_t)4 * 32 * 63 * 256 * 4);
constexpr size_t WS_SLOTTOK = WS_TOKREC + al4k((size_t)TT * 32);
constexpr size_t WS_XC = WS_SLOTTOK + al4k((size_t)8 * TT * 4);
constexpr size_t WS_WIN = WS_XC + al4k((size_t)TCX * D * 4);
constexpr size_t WS_WGLU = WS_WIN + (size_t)4 * DIN * D * 2;
constexpr size_t WS_WPA = WS_WGLU + (size_t)4 * 512 * 512 * 2;
constexpr size_t WS_WPB = WS_WPA + (size_t)4 * 1024 * 512 * 2;
constexpr size_t WS_WOUT = WS_WPB + (size_t)4 * 1024 * 512 * 2;
constexpr size_t WS_FFN1 = WS_WOUT + (size_t)4 * 1024 * 1024 * 2;
constexpr size_t WS_FFN2 = WS_FFN1 + (size_t)2 * 2 * DFF * D * 2;
constexpr size_t WS_EXP1 = WS_FFN2 + (size_t)2 * D * DFF * 2;
constexpr size_t WS_XPARK = WS_EXP1;
constexpr size_t WS_EXP2 = WS_EXP1 + (size_t)2 * 8 * 2 * DFFE * D * 2;
constexpr size_t WS_HB = WS_EXP2 + (size_t)2 * 8 * D * DFFE * 2;
constexpr size_t WS_R = WS_HB + (size_t)TT * D * 2;
constexpr size_t WS_QB = WS_R;
constexpr size_t WS_KB = WS_QB + (size_t)TT * 512 * 2;
constexpr size_t WS_VB = WS_KB + (size_t)TT * 128 * 2;
constexpr size_t WS_AG = WS_VB + (size_t)TT * 128 * 2;
constexpr size_t WS_SGA = WS_AG + (size_t)NG * SSM_RPAD * AG_PITCH * 2;
constexpr size_t WS_SGB = WS_SGA + (size_t)TT * D * 2;
constexpr size_t WS_AO = WS_SGB + (size_t)TT * D * 2;
constexpr size_t WS_GY = WS_AO + (size_t)TT * 512 * 2;
constexpr size_t WS_SB = WS_GY + (size_t)TT * 512 * 2;
constexpr size_t WS_H8 = WS_SB;
constexpr size_t WS_MB = WS_SB + (size_t)TT * 512 * 2;
constexpr size_t WS_EF = WS_MB + (size_t)TT * D * 2;
constexpr size_t WS_W1 = WS_EF + (size_t)NG * SSM_RPAD * 256 * 4;
constexpr size_t WS_BTY = WS_W1 + (size_t)NG * 256 * 512 * 2;
constexpr size_t WS_MIX_END = WS_BTY + (size_t)NG * 512 * 768 * 2;
constexpr size_t WS_MO = WS_QB;
static_assert(WS_MO + (size_t)TT * D * 2 <= WS_SGA, "MO overlay");
constexpr size_t WS_HID = WS_R;
constexpr size_t WS_FY = WS_HID + (size_t)TT * DFF * 2;
constexpr size_t WS_FFN_END = WS_FY + (size_t)TT * D * 2;
constexpr size_t WS_ASORT = WS_R;
constexpr size_t WS_YSLOT = WS_ASORT + (size_t)MOE_MAXTILES * 256 * D * 2;
constexpr size_t WS_HIDM = WS_YSLOT + (size_t)MOE_MAXTILES * 256 * D * 2;
constexpr size_t WS_MOE_END = WS_HIDM + (size_t)MOE_MAXTILES * 256 * DFFE;
constexpr size_t cmax(size_t a, size_t b) { return a > b ? a : b; }
constexpr size_t WS_END = cmax(cmax(WS_MIX_END, WS_FFN_END), WS_MOE_END);
static_assert(WS_END <= (size_t)1113000000, "workspace budget");

constexpr int CW_TMO = 0;
constexpr int CW_BAR = 4096;
constexpr int CW_QUEUE = 8192;
constexpr int CW_CURSOR = 12288;
constexpr int CW_BG = 16384;
constexpr int CW_DONE = 20480;

constexpr int RING_BYTES = 131072;
constexpr int TAB_OFF = RING_BYTES;
constexpr int MISC_OFF = RING_BYTES + 12288;
constexpr int LDS_BYTES = 147456;

#define RLX_AGENT __ATOMIC_RELAXED, __HIP_MEMORY_SCOPE_AGENT
#define LDS_WAIT() asm volatile("s_waitcnt lgkmcnt(0)" ::: "memory")
#define VM_WAIT() asm volatile("s_waitcnt vmcnt(0)" ::: "memory")

__device__ __forceinline__ unsigned pk_bf16(float lo, float hi) { f32x2 v = {lo, hi}; bf16x2_t b = __builtin_convertvector(v, bf16x2_t); return __builtin_bit_cast(unsigned, b); }
__device__ __forceinline__ float clamp448(float x) { return fminf(fmaxf(x, -448.0f), 448.0f); }
__device__ __forceinline__ unsigned pk_fp8x4(float a, float b, float c, float d) {
    int w = __builtin_amdgcn_cvt_pk_fp8_f32(clamp448(a), clamp448(b), 0, false); w = __builtin_amdgcn_cvt_pk_fp8_f32(clamp448(c), clamp448(d), w, true); return (unsigned)w; }
__device__ __forceinline__ unsigned pk_fp8x4_nc(float a, float b, float c, float d) { int w = __builtin_amdgcn_cvt_pk_fp8_f32(a, b, 0, false); w = __builtin_amdgcn_cvt_pk_fp8_f32(c, d, w, true); return (unsigned)w; }
__device__ __forceinline__ float bf_lo(unsigned u) { return __uint_as_float(u << 16); }
__device__ __forceinline__ float bf_hi(unsigned u) { return __uint_as_float(u & 0xffff0000u); }
__device__ __forceinline__ float fast_rcp(float x) { return __builtin_amdgcn_rcpf(x); }
__device__ __forceinline__ float fast_exp2(float x) { return __builtin_amdgcn_exp2f(x); }
__device__ __forceinline__ float sigmoid_f(float x) { return fast_rcp(1.0f + fast_exp2(-LOG2E * x)); }
__device__ __forceinline__ float silu_f(float x) { return x * sigmoid_f(x); }
__device__ __forceinline__ f32x2 sigmoid2(f32x2 x) { const f32x2 t = x * (-LOG2E); f32x2 e; e.x = fast_exp2(t.x); e.y = fast_exp2(t.y); const f32x2 d = e + 1.0f; f32x2 r; r.x = fast_rcp(d.x); r.y = fast_rcp(d.y); return r; }
__device__ __forceinline__ f32x4 gelu4(const f32x4& v);
__device__ __forceinline__ f32x4 sigmoid4(const f32x4& v) { const f32x2 a = sigmoid2((f32x2){v[0], v[1]}), b = sigmoid2((f32x2){v[2], v[3]}); return (f32x4){a.x, a.y, b.x, b.y}; }
__device__ __forceinline__ float gelu_tanh_f(float x) { const float u = 1.5957691216057308f * (x + 0.044715f * x * x * x); return x * fast_rcp(1.0f + fast_exp2(-LOG2E * u)); }
__device__ __forceinline__ float wave_sum(float v) {
#define DPPF(x, ctrl, rm) __builtin_bit_cast(float, __builtin_amdgcn_update_dpp(0, __builtin_bit_cast(int, (x)), (ctrl), (rm), 0xF, false))
    v += DPPF(v, 0xB1, 0xF); v += DPPF(v, 0x4E, 0xF); v += DPPF(v, 0x141, 0xF); v += DPPF(v, 0x140, 0xF);
    v += DPPF(v, 0x142, 0xA); v += DPPF(v, 0x143, 0xC);
#undef DPPF
    return __builtin_bit_cast(float, __builtin_amdgcn_readlane(__builtin_bit_cast(int, v), 63));
}

__device__ __forceinline__ f32x4 gelu4(const f32x4& v) { const f32x4 u = (v + (v * v * v) * 0.044715f) * 1.5957691216057308f; return v * sigmoid4(u); }
namespace pg8 {
constexpr int BM = 256, BK = 64, HALF = 128, HTB = HALF * BK * 2, STAGE_BYTES = 8 * HTB, NXCD = 8, WGM = 8;
__host__ __device__ __forceinline__ int lds_byte(int r, int c) { const int st = (r >> 4) * 2 + (c >> 5), rr = r & 15, cc = c & 31, ob = rr * 64 + cc * 2; return st * 1024 + (ob ^ (((ob >> 9) & 1) << 5)); }
__host__ __device__ __forceinline__ void stage_rc(int b, int& R, int& C) { const int st = b / 1024, sb = b % 1024, swz = sb ^ (((sb >> 9) & 1) << 5); R = (st >> 1) * 16 + swz / 64; C = (st & 1) * 32 + (swz % 64) / 2; }
__host__ __device__ __forceinline__ int perm32(int rho) { const int n = rho >> 4, i = rho & 15; return 8 * (i >> 2) + 4 * n + (i & 3); }
__device__ __forceinline__ int xcd_remap(int wgid, int nwg) { const int q = nwg / NXCD, r = nwg % NXCD, xcd = wgid % NXCD, off = wgid / NXCD; return (xcd < r ? xcd * (q + 1) : r * (q + 1) + (xcd - r) * q) + off; }

struct Unit { int pm, pn, g; };

struct DenseOrder {
    int nM, nN, nwg, G, c, skew;
    __device__ void init(int nM_, int nN_, int G_, int c_, int skew_ = 0) { nM = nM_; nN = nN_; nwg = nM * nN; G = G_; c = c_; skew = (skew_ && G_ == 256) ? 1 : 0; }
    __device__ __forceinline__ bool next(int i, Unit& u) const {
        long L = (long)i * G + c;
        if (skew) { if (c < 64) { if (i > 0) return false; L = c; } else { const int cc = c - 64; if (i == 0) L = 64 + cc; else if (i == 1) L = 256 + cc; else if (i == 2) L = 448 + cc; else return false; } }
        if (L >= nwg) return false;
        const int wgid = xcd_remap((int)L, nwg);
        const int nig = WGM * nN, gid = wgid / nig, fm = gid * WGM, gsz = (nM - fm) < WGM ? (nM - fm) : WGM;
        u.pm = fm + ((wgid % nig) % gsz); u.pn = (wgid % nig) / gsz; u.g = 0; return true;
    }
    __device__ __forceinline__ bool slack() const { const int r = nwg % G; return !skew && r != 0 && c >= r; }
};
struct GroupOrder {
    int nmt, npn, nwg, G, c;
    __device__ void init(int ngrp, int nmt_, int npn_, int G_, int c_) { nmt = nmt_; npn = npn_; nwg = ngrp * nmt * npn; G = G_; c = c_; }
    __device__ __forceinline__ bool next(int i, Unit& u) const {
        const long L = (long)i * G + c; if (L >= nwg) return false;
        const int w = xcd_remap((int)L, nwg);
        const int per = nmt * npn; u.g = w / per; const int r = w % per; u.pm = r / npn; u.pn = r % npn; return true;
    }
};
struct MoeOrder {
    int t0, npn, nwg, G, c; const LAS int* tile_e;
    __device__ void init(int t0_, int t1_, int npn_, int G_, int c_, const LAS int* te) { t0 = t0_; npn = npn_; nwg = (t1_ > t0_ ? (t1_ - t0_) : 0) * npn_; G = G_; c = c_; tile_e = te; }
    __device__ __forceinline__ bool next(int i, Unit& u) const {
        const long L = (long)i * G + c; if (L >= nwg) return false;
        const int w = xcd_remap((int)L, nwg);
        if (npn == 28) { const int hsz = (nwg / 28) * 14, ph = (w >= hsz) ? 1 : 0, r = w - ph * hsz; u.pm = t0 + r / 14; u.pn = ph * 14 + r % 14; }
        else { u.pm = t0 + w / npn; u.pn = w % npn; }
        u.g = tile_e[u.pm]; return true;
    }
    __device__ __forceinline__ bool slack() const { const int r = nwg % G; return r != 0 && c >= r; }
};

typedef int v8i32_t __attribute__((ext_vector_type(8)));
typedef int v4i32_t __attribute__((ext_vector_type(4)));
template <int WSC  , class Ops, class Epi, class Sched>
__device__ __forceinline__ void gemm_phase(LAS unsigned char* lds, int wave_id, const Ops& O, const Sched& S, const Epi& E) {
    int wid_ = wave_id; asm volatile("" : "+s"(wid_));
    int lane_ = (int)__builtin_amdgcn_mbcnt_hi(~0u, __builtin_amdgcn_mbcnt_lo(~0u, 0u)) & 63; asm volatile("" : "+v"(lane_));
    const int wid = wid_, lane = lane_, tid = wid * 64 + lane, wr = wid >> 2, wc = wid & 3, fr = lane & 15, fq = lane >> 4;
    const int K = O.K, nt = K / 128, lda = O.lda, ldb = O.ldb;
    unsigned voffA[2], voffB[2];
#pragma unroll
    for (int i = 0; i < 2; ++i) { int R, C; stage_rc(tid * 16 + i * 8192, R, C); const int Rb = Epi::PERM ? ((R & ~31) + perm32(R & 31)) : R;
        voffA[i] = (unsigned)(R * lda + C * 2); voffB[i] = (unsigned)(Rb * ldb + C * 2); }
    const unsigned kstep = 128u;
    const unsigned hstepA = (unsigned)HALF * (unsigned)lda, hstepB = (unsigned)HALF * (unsigned)ldb;
    const __amdgpu_buffer_rsrc_t rsA = __builtin_amdgcn_make_buffer_rsrc((void*)O.A, 0, -1, 0x00020000), rsB = __builtin_amdgcn_make_buffer_rsrc((void*)O.B, 0, -1, 0x00020000);
    constexpr bool F8 = (WSC != 0);
#ifndef F8_ALIGN
#define F8_ALIGN 1
#endif
    constexpr bool ALIGN_EPI = F8 ? (F8_ALIGN != 0) : true;
    const int f8scale = WSC;
    const unsigned ldsw = (unsigned)wid * 1024u;
    const int aoff = lds_byte(wr * 64 + fr, fq * 8), boff = lds_byte(wc * 32 + fr, fq * 8);
#define PG8_SA(b, h) (((b) * 2 + (h)) * HTB)
#define PG8_SB(b, h) ((4 + (b) * 2 + (h)) * HTB)
#define PG8_STAGE(bufoff, soff, voff) do { _Pragma("unroll") for (int _i = 0; _i < 2; ++_i) \
        __builtin_amdgcn_raw_ptr_buffer_load_lds((&(voff)[0] == &voffA[0]) ? rsA : rsB, (LAS void*)(lds + (bufoff) + ldsw + _i * 8192), 16, (int)(voff)[_i], (int)(soff), 0, 0); } while (0)
#define PG8_CAT(p) __builtin_shufflevector(*(const LAS v4i32_t*)(p), *(const LAS v4i32_t*)((p) + 1024), 0, 1, 2, 3, 4, 5, 6, 7)
#define PG8_LDA(dst, b, h) do { _Pragma("unroll") for (int m = 0; m < 4; ++m) { if constexpr (F8) dst##8[m] = PG8_CAT(lds + PG8_SA(b, h) + aoff + m * 2048); else { _Pragma("unroll") for (int k = 0; k < 2; ++k) dst[m][k] = *(const LAS bf16x8*)(lds + PG8_SA(b, h) + aoff + m * 2048 + k * 1024); } } } while (0)
#define PG8_LDB(dst, b, h) do { _Pragma("unroll") for (int n = 0; n < 2; ++n) { if constexpr (F8) dst##8[n] = PG8_CAT(lds + PG8_SB(b, h) + boff + n * 2048); else { _Pragma("unroll") for (int k = 0; k < 2; ++k) dst[n][k] = *(const LAS bf16x8*)(lds + PG8_SB(b, h) + boff + n * 2048 + k * 1024); } } } while (0)
#define PG8_MMA(ai, bj, At, Bt) do { __builtin_amdgcn_s_setprio(1); \
        if constexpr (F8) { asm volatile("s_nop 1\n\t" \
            "v_mfma_scale_f32_16x16x128_f8f6f4 %0, %8, %10, %0, %14, %14 op_sel_hi:[0,0,0]\n\t" "v_mfma_scale_f32_16x16x128_f8f6f4 %1, %9, %10, %1, %14, %14 op_sel_hi:[0,0,0]\n\t" \
            "v_mfma_scale_f32_16x16x128_f8f6f4 %2, %8, %11, %2, %14, %14 op_sel_hi:[0,0,0]\n\t" "v_mfma_scale_f32_16x16x128_f8f6f4 %3, %9, %11, %3, %14, %14 op_sel_hi:[0,0,0]\n\t" \
            "v_mfma_scale_f32_16x16x128_f8f6f4 %4, %8, %12, %4, %14, %14 op_sel_hi:[0,0,0]\n\t" "v_mfma_scale_f32_16x16x128_f8f6f4 %5, %9, %12, %5, %14, %14 op_sel_hi:[0,0,0]\n\t" \
            "v_mfma_scale_f32_16x16x128_f8f6f4 %6, %8, %13, %6, %14, %14 op_sel_hi:[0,0,0]\n\t" "v_mfma_scale_f32_16x16x128_f8f6f4 %7, %9, %13, %7, %14, %14 op_sel_hi:[0,0,0]" \
            : "+v"(acc[ai][bj][0][0]), "+v"(acc[ai][bj][0][1]), "+v"(acc[ai][bj][1][0]), "+v"(acc[ai][bj][1][1]), "+v"(acc[ai][bj][2][0]), "+v"(acc[ai][bj][2][1]), "+v"(acc[ai][bj][3][0]), "+v"(acc[ai][bj][3][1]) \
            : "v"(Bt##8[0]), "v"(Bt##8[1]), "v"(At##8[0]), "v"(At##8[1]), "v"(At##8[2]), "v"(At##8[3]), "v"(f8scale)); } \
        else { _Pragma("unroll") for (int m = 0; m < 4; ++m) _Pragma("unroll") for (int n = 0; n < 2; ++n) _Pragma("unroll") for (int k = 0; k < 2; ++k) \
            acc[ai][bj][m][n] = __builtin_amdgcn_mfma_f32_16x16x32_bf16(Bt[n][k], At[m][k], acc[ai][bj][m][n], 0, 0, 0); } \
        __builtin_amdgcn_s_setprio(0); } while (0)
#define PG8_WAIT_V(n) asm volatile("s_waitcnt vmcnt(" #n ")" ::: "memory")
#define PG8_WAIT_L(n) asm volatile("s_waitcnt lgkmcnt(" #n ")" ::: "memory")
#define PG8_BAR __builtin_amdgcn_s_barrier()
#define PG8_SCHED __builtin_amdgcn_sched_barrier(0)
    Unit cur, nxt; int ui = 0;
    if (!S.next(0, cur)) return;
    f32x4 acc[2][2][4][2];
#pragma unroll
    for (int a = 0; a < 2; ++a)
#pragma unroll
        for (int b = 0; b < 2; ++b)
#pragma unroll
            for (int m = 0; m < 4; ++m)
#pragma unroll
                for (int n = 0; n < 2; ++n) acc[a][b][m][n] = (f32x4){0.f, 0.f, 0.f, 0.f};
    bf16x8 At[4][2], B0[2][2], B1[2][2]; v8i32_t At8[4], B08[2], B18[2];
    unsigned cA = __builtin_amdgcn_readfirstlane(O.a_off(cur)), cB = __builtin_amdgcn_readfirstlane(O.b_off(cur));
    PG8_STAGE(PG8_SB(0, 0), cB, voffB); PG8_STAGE(PG8_SB(0, 1), cB + hstepB, voffB); PG8_STAGE(PG8_SA(0, 0), cA, voffA); PG8_STAGE(PG8_SA(0, 1), cA + hstepA, voffA);
    if (wr == 1) PG8_BAR;
    PG8_WAIT_V(2); PG8_BAR;
    PG8_STAGE(PG8_SB(1, 0), cB + kstep, voffB); PG8_STAGE(PG8_SA(1, 0), cA + kstep, voffA); PG8_STAGE(PG8_SB(1, 1), cB + hstepB + kstep, voffB);
    PG8_WAIT_V(6); PG8_BAR;
    for (;;) {
        const bool has_next = S.next(ui + 1, nxt);
        const unsigned nA = has_next ? __builtin_amdgcn_readfirstlane(O.a_off(nxt)) : cA, nB = has_next ? __builtin_amdgcn_readfirstlane(O.b_off(nxt)) : cB;
        for (int t = 0; t < nt; t += 2) {
            const bool last = (t == nt - 2);
            const unsigned a1 = cA + (unsigned)(t + 1) * kstep;
            const unsigned a2 = last ? nA : cA + (unsigned)(t + 2) * kstep, b2 = last ? nB : cB + (unsigned)(t + 2) * kstep;
            const unsigned a3 = a2 + kstep, b3 = b2 + kstep;
            PG8_LDB(B0, 0, 0); PG8_LDB(B1, 0, 1); PG8_SCHED; PG8_LDA(At, 0, 0); PG8_STAGE(PG8_SA(1, 1), a1 + hstepA, voffA);
            PG8_WAIT_V(8); PG8_WAIT_L(0); PG8_BAR; PG8_MMA(0, 0, At, B0); PG8_MMA(0, 1, At, B1); PG8_BAR; PG8_SCHED;
            PG8_LDA(At, 0, 1); PG8_STAGE(PG8_SB(0, 0), b2, voffB); PG8_STAGE(PG8_SB(0, 1), b2 + hstepB, voffB); PG8_STAGE(PG8_SA(0, 0), a2, voffA);
            PG8_WAIT_V(8); PG8_WAIT_L(0); PG8_BAR; PG8_MMA(1, 0, At, B0); PG8_MMA(1, 1, At, B1); PG8_BAR; PG8_SCHED;
            PG8_LDB(B0, 1, 0); PG8_LDB(B1, 1, 1); PG8_SCHED; PG8_LDA(At, 1, 0); PG8_STAGE(PG8_SA(0, 1), a2 + hstepA, voffA);
            PG8_WAIT_V(8); PG8_WAIT_L(0); PG8_BAR; PG8_MMA(0, 0, At, B0); PG8_MMA(0, 1, At, B1); PG8_BAR; PG8_SCHED;
            PG8_LDA(At, 1, 1); PG8_STAGE(PG8_SB(1, 0), b3, voffB); PG8_STAGE(PG8_SB(1, 1), b3 + hstepB, voffB); PG8_STAGE(PG8_SA(1, 0), a3, voffA);
            PG8_WAIT_V(8); PG8_WAIT_L(0); PG8_BAR; PG8_MMA(1, 0, At, B0); PG8_MMA(1, 1, At, B1); PG8_BAR; PG8_SCHED;
        }
        if constexpr (ALIGN_EPI) { if (wr == 0) PG8_BAR; }
        if constexpr (F8) asm volatile("s_nop 15\n\ts_nop 7" ::: "memory");
        E(acc, cur, wr, wc, fr, fq);
        if (!has_next) break;
#pragma unroll
        for (int a = 0; a < 2; ++a)
#pragma unroll
            for (int b = 0; b < 2; ++b)
#pragma unroll
                for (int m = 0; m < 4; ++m)
#pragma unroll
                    for (int n = 0; n < 2; ++n) acc[a][b][m][n] = (f32x4){0.f, 0.f, 0.f, 0.f};
        cur = nxt; cA = nA; cB = nB; ++ui;
        if constexpr (ALIGN_EPI) { if (wr == 1) PG8_BAR; }
    }
    PG8_WAIT_V(0);
    if constexpr (!ALIGN_EPI) { if (wr == 0) PG8_BAR; }
    PG8_BAR;
#undef PG8_SA
#undef PG8_SB
#undef PG8_STAGE
#undef PG8_CAT
#undef PG8_LDA
#undef PG8_LDB
#undef PG8_MMA
#undef PG8_WAIT_V
#undef PG8_WAIT_L
#undef PG8_BAR
#undef PG8_SCHED
}
}
using pg8::Unit;

#define XB_TMO      128
#define XB_XCNT(j)  (256  + 64 * (j))
#define XB_XSUB(j)  (1280 + 64 * (j))
#define XB_XGEN(j)  (2304 + 64 * (j))
#define XB_TOP      3328
#define XB_TOPGEN   3392
#define XCD_BAR_WORDS 3456
#define XB_SPIN_CAP (1u << 18)
__device__ __forceinline__ unsigned xb_ld(unsigned* p)              { return __hip_atomic_load(p, __ATOMIC_RELAXED, __HIP_MEMORY_SCOPE_AGENT); }
__device__ __forceinline__ unsigned xb_add(unsigned* p, unsigned v) { return __hip_atomic_fetch_add(p, v, __ATOMIC_RELAXED, __HIP_MEMORY_SCOPE_AGENT); }
__device__ __forceinline__ unsigned xb_xcc_id() { return (unsigned)__builtin_amdgcn_s_getreg((3 << 11) | 20) & 0xFu; }
#define XB_SPIN(cond, bar) do { unsigned _sp = 0; while (cond) { __builtin_amdgcn_s_sleep(1); \
    if ((++_sp & 255u) == 0u) { if (xb_ld(&(bar)[XB_TMO])) break; if (_sp > XB_SPIN_CAP) { atomicAdd(&(bar)[XB_TMO], 1u); break; } } } } while (0)
struct XcdBarrier { unsigned* bar; unsigned x; volatile LAS unsigned* st; };
__device__ __forceinline__ XcdBarrier xcd_barrier_post(unsigned* bar, volatile LAS unsigned* st) {
    XcdBarrier b; b.bar = bar; b.x = xb_xcc_id(); b.st = st;
    if (threadIdx.x == 0) (void)xb_add(&bar[XB_XCNT(b.x)], 1u);
    return b;
}
__device__ __forceinline__ void xcd_barrier_complete(unsigned* bar, unsigned x, unsigned& nloc, unsigned& nx) {
    const unsigned G = gridDim.x * gridDim.y * gridDim.z;
    unsigned sum, cnt, mine, sp = 0u;
    for (;;) {
        sum = 0u; cnt = 0u; mine = 0u;
#pragma unroll
        for (unsigned j = 0; j < 16; ++j) { const unsigned c = xb_ld(&bar[XB_XCNT(j)]); sum += c; cnt += (c > 0u) ? 1u : 0u; mine = (j == x) ? c : mine; }
        if (sum == G) break;
        __builtin_amdgcn_s_sleep(1);
        if ((++sp & 255u) == 0u) { if (xb_ld(&bar[XB_TMO])) break; if (sp > XB_SPIN_CAP) { atomicAdd(&bar[XB_TMO], 1u); break; } }
    }
    nloc = mine > 0u ? mine : 1u; nx = cnt > 0u ? cnt : 1u;
}
__device__ __forceinline__ void xcd_barrier(const XcdBarrier& b, bool leader  ) {
    asm volatile("s_waitcnt vmcnt(0)" ::: "memory");
    __syncthreads();
    if (leader) {
        unsigned* bar = b.bar;
        __builtin_amdgcn_s_waitcnt(0);
        unsigned nloc = b.st[0], nx = b.st[1];
        if (nloc == 0u) { xcd_barrier_complete(bar, b.x, nloc, nx); b.st[0] = nloc; b.st[1] = nx; }
        const unsigned old = xb_add(&bar[XB_XSUB(b.x)], 1u);
        const unsigned gen = old / nloc;
        if (old + 1u == (gen + 1u) * nloc) {
            __builtin_amdgcn_fence(__ATOMIC_RELEASE, "agent");
            asm volatile("s_waitcnt vmcnt(0)" ::: "memory");
            const unsigned og = xb_add(&bar[XB_TOP], 1u);
            const unsigned tg = og / nx;
            if (og + 1u == (tg + 1u) * nx) xb_add(&bar[XB_TOPGEN], 1u);
            else XB_SPIN(xb_ld(&bar[XB_TOPGEN]) == tg, bar);
            __builtin_amdgcn_fence(__ATOMIC_ACQUIRE, "agent");
            xb_add(&bar[XB_XGEN(b.x)], 1u);
            asm volatile("s_waitcnt vmcnt(0)" ::: "memory");
        } else {
            XB_SPIN(xb_ld(&bar[XB_XGEN(b.x)]) == gen, bar);
            __builtin_amdgcn_fence(__ATOMIC_ACQUIRE, "agent");
            asm volatile("s_waitcnt vmcnt(0)" ::: "memory");
        }
    }
    __syncthreads();
}

struct Args { const float* in[30]; float* out; unsigned char* ws; };
enum { I_X = 0, I_C, I_CTX, I_CCTX, I_WMOD, I_BMOD, I_NORMG, I_WIN, I_SINK, I_ARE, I_AIM, I_LOGDT, I_BRE, I_BIM, I_CRE, I_CIM, I_SSMD, I_WGLU, I_BGLU,
       I_WPA, I_WPB, I_WOUT, I_FGATE, I_FUP, I_FDOWN, I_WROUTER, I_BROUTER, I_EGATE, I_EUP, I_EDOWN };

struct Frame {
    LAS unsigned char* lds;
    int tid, lane, wave, G, vcu;
};
__device__ __forceinline__ Frame relaunder(const Frame& F0) { Frame F = F0; asm volatile("" : "+s"(F.wave)); asm volatile("" : "+s"(F.vcu));
    F.lane = (int)__builtin_amdgcn_mbcnt_hi(~0u, __builtin_amdgcn_mbcnt_lo(~0u, 0u)) & 63; asm volatile("" : "+v"(F.lane)); F.tid = F.wave * 64 + F.lane; return F; }
constexpr int PTAB_OFF = RING_BYTES + 12288 + 256;
__device__ __forceinline__ unsigned long long ptab_get(const Frame& F, int i) {
    unsigned off = PTAB_OFF + 8 * i; asm volatile("" : "+v"(off));
    volatile LAS unsigned* p = (volatile LAS unsigned*)(F.lds + off);
    const unsigned lo = __builtin_amdgcn_readfirstlane(p[0]), hi = __builtin_amdgcn_readfirstlane(p[1]);
    return ((unsigned long long)hi << 32) | lo;
}
#define INP(i) ((const float*)(const GAS float*)ptab_get(F, (i)))
#define OUTP() ((float*)(GAS float*)ptab_get(F, 30))
#define WSP() ((unsigned char*)(GAS unsigned char*)ptab_get(F, 31))
#define CTLP() ((gu32*)(WSP() + WS_CTL))

template <int MAP  >
__device__ __forceinline__ int row_map(int n) {
    if (MAP == 1) { if (n < 640) { const int d = n & 63; return (n & ~63) + (d < 32 ? 2 * d : 2 * (d - 32) + 1); } return n; }
    if (MAP == 2) return (n >> 7) * 256 + (n & 127);
    if (MAP == 3) return (n >> 7) * 256 + 128 + (n & 127);
    if (MAP == 4) return n - NQKVU;
    return n;
}
template <int MAP>
__device__ __forceinline__ void transpose_item8(const float* W, int K, int N, unsigned char* WT, float wmul, LAS float* scr, int item, int lane) {
    const int nblk = N / 32, kb = item / nblk, nb = item % nblk, k0 = 64 * kb, n0 = 32 * nb;
    { const int kr = lane >> 3, nc = (lane & 7) * 4; f32x4 v[8];
#pragma unroll
      for (int i = 0; i < 8; ++i) v[i] = *(const f32x4*)(W + (size_t)(k0 + 8 * i + kr) * N + n0 + nc);
#pragma unroll
      for (int i = 0; i < 8; ++i) { LAS float* d = scr + (8 * i + kr) * 33 + nc; d[0] = v[i].x * wmul; d[1] = v[i].y * wmul; d[2] = v[i].z * wmul; d[3] = v[i].w * wmul; } }
    LDS_WAIT(); asm volatile("" ::: "memory");
    const int c = lane & 7;
#pragma unroll
    for (int j = 0; j < 4; ++j) { const int n = (lane >> 3) + 8 * j; const LAS float* s = scr + (8 * c) * 33 + n;
        u32x2 o; o.x = pk_fp8x4(s[0 * 33], s[1 * 33], s[2 * 33], s[3 * 33]); o.y = pk_fp8x4(s[4 * 33], s[5 * 33], s[6 * 33], s[7 * 33]);
        *(u32x2*)(WT + (size_t)row_map<MAP>(n0 + n) * K + k0 + 8 * c) = o; }
    LDS_WAIT(); asm volatile("" ::: "memory");
}
template <int MAP>
__device__ __forceinline__ void transpose_item(const float* W, int K, int N, bf16* WT, LAS float* scr, int item, int lane) {
    const int nblk = N / 32, kb = item / nblk, nb = item % nblk, k0 = 64 * kb, n0 = 32 * nb;
    { const int kr = lane >> 3, nc = (lane & 7) * 4; f32x4 v[8];
#pragma unroll
      for (int i = 0; i < 8; ++i) v[i] = *(const f32x4*)(W + (size_t)(k0 + 8 * i + kr) * N + n0 + nc);
#pragma unroll
      for (int i = 0; i < 8; ++i) { LAS float* d = scr + (8 * i + kr) * 33 + nc; d[0] = v[i].x; d[1] = v[i].y; d[2] = v[i].z; d[3] = v[i].w; } }
    LDS_WAIT(); asm volatile("" ::: "memory");
    const int c = lane & 7;
#pragma unroll
    for (int j = 0; j < 4; ++j) { const int n = (lane >> 3) + 8 * j; const LAS float* s = scr + (8 * c) * 33 + n;
        u32x4 o; o.x = pk_bf16(s[0 * 33], s[1 * 33]); o.y = pk_bf16(s[2 * 33], s[3 * 33]); o.z = pk_bf16(s[4 * 33], s[5 * 33]); o.w = pk_bf16(s[6 * 33], s[7 * 33]);
        *(u32x4*)(WT + (size_t)row_map<MAP>(n0 + n) * K + k0 + 8 * c) = o; }
    LDS_WAIT(); asm volatile("" ::: "memory");
}

constexpr int MOD_ITEMS = 4 * 24 * 16;
__device__ __forceinline__ void mod_item(const Frame& F, int item);
__device__ __forceinline__ void p0_weights(const Frame& F) {
    LAS float* scr = (LAS float*)(F.lds + F.wave * 8448);
    const int gw = F.vcu * 8 + F.wave, NGW = F.G * 8;
    constexpr int I_IN = 16 * 104, I_GLU = 8 * 16, I_PA = 8 * 32, I_OUT = 16 * 32, PER_L = I_IN + I_GLU + 2 * I_PA + I_OUT;
    constexpr int I_F = 16 * 88, PER_F = 3 * I_F;
    constexpr int N1 = 4 * PER_L, N2 = N1 + 2 * PER_F;
    bf16* ws_win = (bf16*)(WSP() + WS_WIN); bf16* ws_glu = (bf16*)(WSP() + WS_WGLU); bf16* ws_pa = (bf16*)(WSP() + WS_WPA); bf16* ws_pb = (bf16*)(WSP() + WS_WPB);
    bf16* ws_out = (bf16*)(WSP() + WS_WOUT); unsigned char* ws_f1 = WSP() + WS_FFN1; unsigned char* ws_f2 = WSP() + WS_FFN2;
    for (int it0 = gw; it0 < N2 + MOD_ITEMS; it0 += NGW) {
        if (it0 < MOD_ITEMS) { mod_item(F, it0); continue; }
        const int it = it0 - MOD_ITEMS;
        if (it < N1) {
            const int l = it / PER_L; int r = it % PER_L;
            if (r < I_IN) { unsigned char* wl = (unsigned char*)ws_win + (size_t)l * WIN_L;
                if ((r % 104) < 40) transpose_item<1>(INP(I_WIN) + (size_t)l * D * DIN, D, DIN, (bf16*)wl, scr, r, F.lane);
                else transpose_item8<4>(INP(I_WIN) + (size_t)l * D * DIN, D, DIN, wl + (size_t)NQKVU * D * 2, 64.0f, scr, r, F.lane);
                continue; } r -= I_IN;
            if (r < I_GLU) { transpose_item<0>(INP(I_WGLU) + (size_t)l * 512 * 512, 512, 512, ws_glu + (size_t)l * 512 * 512, scr, r, F.lane); continue; } r -= I_GLU;
            if (r < I_PA) { transpose_item<0>(INP(I_WPA) + (size_t)l * 512 * 1024, 512, 1024, ws_pa + (size_t)l * 1024 * 512, scr, r, F.lane); continue; } r -= I_PA;
            if (r < I_PA) { transpose_item<0>(INP(I_WPB) + (size_t)l * 512 * 1024, 512, 1024, ws_pb + (size_t)l * 1024 * 512, scr, r, F.lane); continue; } r -= I_PA;
            transpose_item<0>(INP(I_WOUT) + (size_t)l * 1024 * 1024, 1024, 1024, ws_out + (size_t)l * 1024 * 1024, scr, r, F.lane);
        } else if (it < N2) {
            const int q = it - N1, j = q / PER_F; int r = q % PER_F; const bool f8 = (F8MASK >> (2 * j)) & 1u;
            unsigned char* d1 = ws_f1 + (size_t)j * 2 * DFF * D * 2; unsigned char* d2 = ws_f2 + (size_t)j * D * DFF * 2;
            if (r < I_F) { if (f8) transpose_item8<2>(INP(I_FGATE) + (size_t)j * D * DFF, D, DFF, d1, 64.0f, scr, r, F.lane); else transpose_item<2>(INP(I_FGATE) + (size_t)j * D * DFF, D, DFF, (bf16*)d1, scr, r, F.lane); continue; } r -= I_F;
            if (r < I_F) { if (f8) transpose_item8<3>(INP(I_FUP) + (size_t)j * D * DFF, D, DFF, d1, 64.0f, scr, r, F.lane); else transpose_item<3>(INP(I_FUP) + (size_t)j * D * DFF, D, DFF, (bf16*)d1, scr, r, F.lane); continue; } r -= I_F;
            if (f8) transpose_item8<0>(INP(I_FDOWN) + (size_t)j * DFF * D, DFF, D, d2, 64.0f, scr, r, F.lane); else transpose_item<0>(INP(I_FDOWN) + (size_t)j * DFF * D, DFF, D, (bf16*)d2, scr, r, F.lane);
        }
    }
}

#ifndef BGN
#define BGN(x) (x)
#endif
constexpr int BGN_GLU = BGN(3), BGN_PB = BGN(4), BGN_OUT = BGN(5), BGN_F1B = BGN(4), BGN_F1F = BGN(2), BGN_F2B = BGN(9), BGN_F2F = BGN(5), BGN_M1 = BGN(2), BGN_M2 = BGN(6);
#ifndef BG_WAVES
#define BG_WAVES 4
#endif
constexpr int BG_I_E = 16 * 112, BG_PER_E = 3 * BG_I_E, BG_ITEMS = 8 * BG_PER_E;
__device__ __forceinline__ void moe_weight_item(const Frame& F, LAS float* scr, int j, int q) {
    const int je = j * 8 + q / BG_PER_E; int r = q % BG_PER_E; const bool f8 = (F8MASK >> (2 * j + 1)) & 1u;
    unsigned char* d1 = WSP() + WS_EXP1 + (size_t)je * 2 * DFFE * D * 2; unsigned char* d2 = WSP() + WS_EXP2 + (size_t)je * D * DFFE * 2;
    if (r < BG_I_E) { if (f8) transpose_item8<2>(INP(I_EGATE) + (size_t)je * D * DFFE, D, DFFE, d1, 64.0f, scr, r, F.lane); else transpose_item<2>(INP(I_EGATE) + (size_t)je * D * DFFE, D, DFFE, (bf16*)d1, scr, r, F.lane); return; } r -= BG_I_E;
    if (r < BG_I_E) { if (f8) transpose_item8<3>(INP(I_EUP) + (size_t)je * D * DFFE, D, DFFE, d1, 64.0f, scr, r, F.lane); else transpose_item<3>(INP(I_EUP) + (size_t)je * D * DFFE, D, DFFE, (bf16*)d1, scr, r, F.lane); return; } r -= BG_I_E;
    if (f8) transpose_item8<0>(INP(I_EDOWN) + (size_t)je * DFFE * D, DFFE, D, d2, 64.0f, scr, r, F.lane); else transpose_item<0>(INP(I_EDOWN) + (size_t)je * DFFE * D, DFFE, D, (bf16*)d2, scr, r, F.lane);
}
__device__ __forceinline__ void bg_work(const Frame& F, int j, int jlast, int nmax, bool drain = false) {
    volatile LAS unsigned* MISC = (volatile LAS unsigned*)(F.lds + MISC_OFF);
    LAS float* scr = (LAS float*)(F.lds + F.wave * 8448);
    while (j <= jlast) {
        __syncthreads();
        if (F.tid == 0) MISC[17] = __hip_atomic_fetch_add(CTLP() + CW_BG + 64 * j, (unsigned)(8 * nmax), RLX_AGENT);
        __syncthreads();
        const unsigned t0 = (unsigned)__builtin_amdgcn_readfirstlane((int)MISC[17]);
        if (t0 >= (unsigned)BG_ITEMS) { ++j; continue; }
        for (int k = 0; k < nmax; ++k) { const unsigned t = t0 + 8u * (unsigned)k + (unsigned)F.wave; if (t < (unsigned)BG_ITEMS) moe_weight_item(F, scr, j, (int)t); }
        if (!drain) break;
    }
}

__device__ __forceinline__ void bg_tail(const Frame& F, int slot, bool count, bool fill, int nbusy, int j) {
    volatile LAS unsigned* MISC = (volatile LAS unsigned*)(F.lds + MISC_OFF);
    gu32* done = CTLP() + CW_DONE + 64 * slot;
    if (count && F.tid == 0) __hip_atomic_fetch_add(done, 1u, RLX_AGENT);
    if (!fill) return;
    LAS float* scr = (LAS float*)(F.lds + F.wave * 8448);
    while (j <= 1) {
        __syncthreads();
        if (F.tid == 0) { unsigned t = 0xffffffffu;
            if (MISC[18] == 0u && __hip_atomic_load(done, RLX_AGENT) < (unsigned)nbusy) t = __hip_atomic_fetch_add(CTLP() + CW_BG + 64 * j, (unsigned)BG_WAVES, RLX_AGENT);
            MISC[17] = t; }
        __syncthreads();
        const unsigned t0 = (unsigned)__builtin_amdgcn_readfirstlane((int)MISC[17]);
        if (t0 == 0xffffffffu) break;
        if (t0 >= (unsigned)BG_ITEMS) { if (j == 1 && F.tid == 0) MISC[18] = 1u; ++j; continue; }
        const unsigned t = t0 + (unsigned)F.wave; if (F.wave < BG_WAVES && t < (unsigned)BG_ITEMS) moe_weight_item(F, scr, j, (int)t);
    }
}

__device__ __forceinline__ void p0_tables(const Frame& F) {
    const int gt = F.vcu * 512 + F.tid, NT = F.G * 512;
    float* ropec = (float*)(WSP() + WS_ROPE); float* ropes = ropec + 4096 * 32;
    for (int i = gt; i < 4096 * 32; i += NT) {
        const int pos = i >> 5, j = i & 31; const float rowf = (float)(pos >> 6), colf = (float)(pos & 63);
        const float invf = powf(10000.0f, -(float)(j & 15) / 16.0f);
        const float ang = (j < 16 ? rowf : colf) * invf;
        ropec[i] = cosf(ang); ropes[i] = sinf(ang);
    }
    f32x2* powt = (f32x2*)(WSP() + WS_POW);
    for (int i = gt; i < 4 * 2 * 32 * 64 * 33; i += NT) {
        const int k = i % 33, q = i / 33;
        const int ldg = q >> 6;
        const float are = INP(I_ARE)[q], aim = INP(I_AIM)[q], dt = expf(INP(I_LOGDT)[ldg]);
        const float mag = expf((float)k * are * dt), ang = (float)k * aim * dt;
        powt[i] = (f32x2){mag * cosf(ang), mag * sinf(ang)};
    }
    f32x2* bbar = (f32x2*)(WSP() + WS_BBAR);
    for (int i = gt; i < 4 * 2 * 32 * 64 * 16; i += NT) {
        const int q = i >> 4, ldg = q >> 6;
        const float are = INP(I_ARE)[q], aim = INP(I_AIM)[q], dt = expf(INP(I_LOGDT)[ldg]);
        const float mag = expf(are * dt), ang = aim * dt;
        const float lr = mag * cosf(ang) - 1.0f, li = mag * sinf(ang);
        const float den = 1.0f / (are * are + aim * aim);
        const float cr = (lr * are + li * aim) * den, ci = (li * are - lr * aim) * den;
        const float br = INP(I_BRE)[i], bi = INP(I_BIM)[i];
        bbar[i] = (f32x2){cr * br - ci * bi, cr * bi + ci * br};
    }
}

constexpr int SC_OFF = 69632;
__device__ __forceinline__ void mod_sc_init(const Frame& F) {
    LAS float* sc = (LAS float*)(F.lds + SC_OFF);
    for (int i = F.tid; i < 9 * 1024; i += 512) { const float v = i < 8192 ? INP(I_C)[i] : INP(I_CCTX)[i - 8192]; sc[i] = v / (1.0f + expf(-v)); }
    __syncthreads();
}
__device__ __forceinline__ void mod_item(const Frame& F, int item) {
    const int kc = item & 15, cc = (item >> 4) % 24, l = item / 384;
    const LAS float* sc = (const LAS float*)(F.lds + SC_OFF) + kc * 64;
    const float* W = INP(I_WMOD) + (size_t)l * D * 6144 + (size_t)(kc * 64) * 6144 + cc * 256 + F.lane * 4;
    f32x4 acc[9];
#pragma unroll
    for (int r = 0; r < 9; ++r) acc[r] = (f32x4){0.f, 0.f, 0.f, 0.f};
    for (int k0 = 0; k0 < 64; k0 += 16) {
        f32x4 w[16];
#pragma unroll
        for (int k = 0; k < 16; ++k) w[k] = *(const f32x4*)(W + (size_t)(k0 + k) * 6144);
#pragma unroll
        for (int k4 = 0; k4 < 16; k4 += 4)
#pragma unroll
            for (int r = 0; r < 9; ++r) { const f32x4 sv = *(const LAS f32x4*)(sc + r * 1024 + k0 + k4);
                acc[r] += w[k4] * sv.x; acc[r] += w[k4 + 1] * sv.y; acc[r] += w[k4 + 2] * sv.z; acc[r] += w[k4 + 3] * sv.w; }
    }
    float* mp = (float*)(WSP() + WS_MODP) + (size_t)kc * 4 * 9 * 6144;
#pragma unroll
    for (int r = 0; r < 9; ++r) *(f32x4*)(mp + ((size_t)l * 9 + r) * 6144 + cc * 256 + F.lane * 4) = acc[r];
}
__device__ __forceinline__ void mod_combine(const Frame& F) {
    const int gt = F.vcu * 512 + F.tid, NT = F.G * 512;
    const float* mp = (const float*)(WSP() + WS_MODP); float* modb = (float*)(WSP() + WS_MOD);
    for (int i = gt; i < 4 * 9 * 6144; i += NT) { const int l = i / (9 * 6144), c = i % 6144;
        float v[16];
#pragma unroll
        for (int k = 0; k < 16; ++k) v[k] = mp[i + (size_t)k * 4 * 9 * 6144];
#pragma unroll
        for (int k = 0; k < 8; ++k) v[k] += v[k + 8];
#pragma unroll
        for (int k = 0; k < 4; ++k) v[k] += v[k + 4];
        modb[i] = ((v[0] + v[2]) + (v[1] + v[3])) + INP(I_BMOD)[l * 6144 + c]; }
}

__device__ __forceinline__ void p1_kfull(const Frame& F) {
    const f32x2* powt = (const f32x2*)(WSP() + WS_POW); const f32x2* bbar = (const f32x2*)(WSP() + WS_BBAR);
    float* kf = (float*)(WSP() + WS_KFULL);
    LAS float* CR = (LAS float*)F.lds; LAS float* CI = CR + 2048; LAS float* BR = CI + 2048; LAS float* BI = BR + 2048;
    LAS float* PR = BI + 2048; LAS float* PI = PR + 2 * 33 * 64;
    for (int it = F.vcu; it < 256; it += F.G) {
        const int l = it >> 6, g = (it >> 1) & 31, half = it & 1;
        __syncthreads();
        for (int i = F.tid; i < 2048; i += 512) { const int dir = i >> 10, p = (i >> 4) & 63, h = i & 15, base = (l * 2 + dir) * 32 + g;
            CR[i] = INP(I_CRE)[(base * 16 + h) * 64 + p]; CI[i] = INP(I_CIM)[(base * 16 + h) * 64 + p];
            const f32x2 bb = bbar[(base * 64 + p) * 16 + h]; BR[i] = bb.x; BI[i] = bb.y; }
        for (int i = F.tid; i < 2 * 64 * 33; i += 512) { const int dir = i / (64 * 33), r = i % (64 * 33), p = r / 33, k = r % 33, base = (l * 2 + dir) * 32 + g;
            const f32x2 pw = powt[(size_t)(base * 64 + p) * 33 + k]; PR[(dir * 33 + k) * 64 + p] = pw.x; PI[(dir * 33 + k) * 64 + p] = pw.y; }
        __syncthreads();
        for (int task = half * 512 + F.tid; task < (half ? 63 * 16 : 512); task += 512) {
            const int li = task >> 4, hb = (task >> 2) & 3, hpb = task & 3, lag = li - 31;
            float acc[4][4];
#pragma unroll
            for (int i = 0; i < 4; ++i)
#pragma unroll
                for (int j = 0; j < 4; ++j) acc[i][j] = 0.f;
#pragma unroll
            for (int dir = 0; dir < 2; ++dir) {
                if ((dir == 0 && lag < 0) || (dir == 1 && lag > 0)) continue;
                const int k = lag < 0 ? -lag : lag;
                for (int p = 0; p < 64; ++p) {
                    const f32x4 cr = *(const LAS f32x4*)(CR + (dir * 64 + p) * 16 + 4 * hb), ci = *(const LAS f32x4*)(CI + (dir * 64 + p) * 16 + 4 * hb);
                    const f32x4 br = *(const LAS f32x4*)(BR + (dir * 64 + p) * 16 + 4 * hpb), bi = *(const LAS f32x4*)(BI + (dir * 64 + p) * 16 + 4 * hpb);
                    const float pr = PR[(dir * 33 + k) * 64 + p], pi = PI[(dir * 33 + k) * 64 + p];
#pragma unroll
                    for (int i = 0; i < 4; ++i) { const float wr = cr[i] * pr - ci[i] * pi, wi = cr[i] * pi + ci[i] * pr;
#pragma unroll
                        for (int j = 0; j < 4; ++j) acc[i][j] += wr * br[j] - wi * bi[j]; }
                }
            }
            if (lag == 0 && hb == hpb) {
#pragma unroll
                for (int i = 0; i < 4; ++i) acc[i][i] += INP(I_SSMD)[l * 512 + g * 16 + 4 * hb + i]; }
#pragma unroll
            for (int i = 0; i < 4; ++i) *(f32x4*)(kf + ((size_t)((l * 32 + g) * 63 + li) * 256 + (4 * hb + i) * 16 + 4 * hpb)) = (f32x4){acc[i][0], acc[i][1], acc[i][2], acc[i][3]};
        }
    }
    __syncthreads();
}

__device__ __forceinline__ void gen_w1(const Frame& F, int l) {
    const int gt = F.vcu * 512 + F.tid, NT = F.G * 512;
    const f32x2* powt = (const f32x2*)(WSP() + WS_POW); const f32x2* bbar = (const f32x2*)(WSP() + WS_BBAR);
    bf16* w1 = (bf16*)(WSP() + WS_W1);
    for (int i0 = gt; i0 < 32 * 256 * 64; i0 += 2 * NT) {
        f32x2 pw[2], bb[2][8]; size_t dst[2]; int ri[2]; bool ok[2];
#pragma unroll
        for (int k = 0; k < 2; ++k) { const int i = i0 + k * NT; ok[k] = i < 32 * 256 * 64; const int ii_ = ok[k] ? i : 0;
            const int k8 = ii_ & 63, n = (ii_ >> 6) & 255, g = ii_ >> 14, dir = n >> 7, p = (n & 127) >> 1, j = k8 >> 1, h0 = (k8 & 1) * 8;
            const int base = ((l * 2 + dir) * 32 + g) * 64 + p; ri[k] = n & 1;
            pw[k] = powt[(size_t)base * 33 + (dir == 0 ? 31 - j : j)];
#pragma unroll
            for (int e = 0; e < 8; ++e) bb[k][e] = bbar[base * 16 + h0 + e];
            dst[k] = (size_t)(g * 256 + n) * 512 + k8 * 8; }
#pragma unroll
        for (int k = 0; k < 2; ++k) if (ok[k]) { float v[8];
#pragma unroll
            for (int e = 0; e < 8; ++e) v[e] = ri[k] == 0 ? (pw[k].x * bb[k][e].x - pw[k].y * bb[k][e].y) : (pw[k].x * bb[k][e].y + pw[k].y * bb[k][e].x);
            u32x4 o; o.x = pk_bf16(v[0], v[1]); o.y = pk_bf16(v[2], v[3]); o.z = pk_bf16(v[4], v[5]); o.w = pk_bf16(v[6], v[7]); *(u32x4*)(w1 + dst[k]) = o; }
    }
}
__device__ __forceinline__ void gen_bty(const Frame& F, int l, int gt, int NT) {
    const f32x2* powt = (const f32x2*)(WSP() + WS_POW); const float* kf = (const float*)(WSP() + WS_KFULL);
    bf16* bty = (bf16*)(WSP() + WS_BTY);
    for (int i0 = gt; i0 < 32 * 512 * 64; i0 += 4 * NT) {
        f32x4 a[4], b[4]; size_t dst[4]; bool ok[4];
#pragma unroll
        for (int k = 0; k < 4; ++k) { const int i = i0 + k * NT; ok[k] = i < 32 * 512 * 64; const int ii_ = ok[k] ? i : 0;
            const int k8 = ii_ & 63, q = ii_ >> 6, n = q & 511, g = q >> 9, ii = n >> 4, h = n & 15, j = k8 >> 1, h0 = (k8 & 1) * 8;
            const float* src = kf + ((size_t)((l * 32 + g) * 63 + (ii - j + 31)) * 256 + h * 16 + h0);
            a[k] = *(const f32x4*)src; b[k] = *(const f32x4*)(src + 4); dst[k] = (size_t)(g * 512 + n) * 768 + k8 * 8; }
#pragma unroll
        for (int k = 0; k < 4; ++k) if (ok[k]) { u32x4 o; o.x = pk_bf16(a[k].x, a[k].y); o.y = pk_bf16(a[k].z, a[k].w); o.z = pk_bf16(b[k].x, b[k].y); o.w = pk_bf16(b[k].z, b[k].w); *(u32x4*)(bty + dst[k]) = o; }
    }
    for (int i0 = gt; i0 < 32 * 512 * 32; i0 += 2 * NT) {
        float cr[2][4], ci[2][4]; f32x2 pw[2][4]; size_t dst[2]; bool ok[2];
#pragma unroll
        for (int k = 0; k < 2; ++k) { const int i = i0 + k * NT; ok[k] = i < 32 * 512 * 32; const int ii_ = ok[k] ? i : 0;
            const int k8 = ii_ & 31, q = ii_ >> 5, n = q & 511, g = q >> 9, ii = n >> 4, h = n & 15, kk = k8 * 8, dir = kk >> 7, p0 = (kk & 127) >> 1, base = ((l * 2 + dir) * 32 + g);
#pragma unroll
            for (int e = 0; e < 4; ++e) { const int p = p0 + e; cr[k][e] = INP(I_CRE)[(base * 16 + h) * 64 + p]; ci[k][e] = INP(I_CIM)[(base * 16 + h) * 64 + p];
                pw[k][e] = powt[(size_t)(base * 64 + p) * 33 + (dir == 0 ? ii + 1 : 32 - ii)]; }
            dst[k] = (size_t)(g * 512 + n) * 768 + 512 + k8 * 8; }
#pragma unroll
        for (int k = 0; k < 2; ++k) if (ok[k]) { float v[8];
#pragma unroll
            for (int e = 0; e < 4; ++e) { v[2 * e] = cr[k][e] * pw[k][e].x - ci[k][e] * pw[k][e].y; v[2 * e + 1] = -(cr[k][e] * pw[k][e].y + ci[k][e] * pw[k][e].x); }
            u32x4 o; o.x = pk_bf16(v[0], v[1]); o.y = pk_bf16(v[2], v[3]); o.z = pk_bf16(v[4], v[5]); o.w = pk_bf16(v[6], v[7]); *(u32x4*)(bty + dst[k]) = o; }
    }
}

struct NpArgs {
    const void* xin_lat; const void* xin_ctx; void* xout_lat; void* xout_ctx;
    const bf16* ysrc;
    const float* gate; int gate_off;
    const float* gA;
    const float* gB;
    const float* modh; int shift_off, scale_off;
    bf16* hout; unsigned char* hout8;
    int nrows;
    const float* wrouter; const float* brouter; unsigned* cursor; unsigned char* tokrec; int* slottok;
    const LAS int* ebase;
};
template <int YSRC  , bool HOUT, bool ROUTE, int H8  , bool XI  , bool XO  >
__device__ __forceinline__ void norm_pass(const Frame& F, const NpArgs& P) {
    const int gw = F.vcu * 8 + F.wave, NGW = F.G * 8, lane = F.lane;
    const int rpw = (P.nrows + NGW - 1) / NGW;
    const int r0 = gw * rpw, r1 = (r0 + rpw) < P.nrows ? (r0 + rpw) : P.nrows;
    LAS float* wr_lds = (LAS float*)F.lds;
    LAS int* lcnt = (LAS int*)(F.lds + 32768);
    LAS int* rec = (LAS int*)(F.lds + 32768 + 64);
    if (ROUTE) {
        for (int i = F.tid; i < 8192; i += 512) wr_lds[i] = P.wrouter[i];
        if (F.tid < 16) lcnt[F.tid] = 0;
        __syncthreads();
    }
    f32x4 gAv[4], gBv[4], gatev[4], shiftv[4], scalev[4];
#pragma unroll
    for (int j = 0; j < 4; ++j) { const int c = 4 * lane + 256 * j;
        if (YSRC) gAv[j] = *(const f32x4*)(P.gA + c);
        if (HOUT) gBv[j] = *(const f32x4*)(P.gB + c); }
    float brt[8];
#pragma unroll
    for (int e = 0; e < 8; ++e) brt[e] = ROUTE ? P.brouter[e] : 0.f;
    int cur_rc = -1;
#define NP_LOAD(ROW, X, YA, YB, W0, W1) do { const int row_ = (ROW); const bool lat_ = row_ < TL; \
        if (XI) { const bf16* xin_ = lat_ ? ((const bf16*)P.xin_lat + (size_t)row_ * D) : ((const bf16*)P.xin_ctx + (size_t)(row_ - TL) * D); \
            _Pragma("unroll") for (int j = 0; j < 4; ++j) X##r[j] = *(const u32x2*)(xin_ + 4 * lane + 256 * j); }   \
        else { const float* xin_ = lat_ ? ((const float*)P.xin_lat + (size_t)row_ * D) : ((const float*)P.xin_ctx + (size_t)(row_ - TL) * D); \
            _Pragma("unroll") for (int j = 0; j < 4; ++j) X[j] = *(const f32x4*)(xin_ + 4 * lane + 256 * j); } \
        if (YSRC == 1) { _Pragma("unroll") for (int j = 0; j < 4; ++j) YA[j] = *(const u32x2*)(P.ysrc + (size_t)row_ * D + 4 * lane + 256 * j); } \
        if (YSRC == 2) { const u32x4 t4_ = trq4; const u32x2 t2_ = trq2;         \
            W0 = __uint_as_float(t2_.x); W1 = __uint_as_float(t2_.y); const size_t s0_ = (size_t)(P.ebase[(int)t4_.x] + (int)t4_.y), s1_ = (size_t)(P.ebase[(int)t4_.z] + (int)t4_.w); \
            _Pragma("unroll") for (int j = 0; j < 4; ++j) { YA[j] = *(const u32x2*)(P.ysrc + s0_ * D + 4 * lane + 256 * j); YB[j] = *(const u32x2*)(P.ysrc + s1_ * D + 4 * lane + 256 * j); } } } while (0)
#define NP_TREC(ROW) do { if (YSRC == 2) { const int* tr_ = (const int*)(P.tokrec + (size_t)(ROW) * 32); trq4 = *(const u32x4*)tr_; trq2 = *(const u32x2*)(tr_ + 4); } } while (0)
    u32x4 trq4 = {0u, 0u, 0u, 0u}; u32x2 trq2 = {0u, 0u};
    f32x4 xn[4]; u32x2 xnr[4], yan[4], ybn[4]; float w0n = 0.f, w1n = 0.f;
    f32x4 xm[4]; u32x2 xmr[4], yam[4], ybm[4]; float w0m = 0.f, w1m = 0.f;
    if (r0 < r1) { NP_TREC(r0); NP_LOAD(r0, xn, yan, ybn, w0n, w1n); }
    if (r0 + 1 < r1) { NP_TREC(r0 + 1); NP_LOAD(r0 + 1, xm, yam, ybm, w0m, w1m); }
    if (r0 + 2 < r1) NP_TREC(r0 + 2);
    for (int row = r0; row < r1; ++row) {
        const bool lat = row < TL; const int rc = lat ? (row >> 12) : 8;
        if (rc != cur_rc) { cur_rc = rc;
#pragma unroll
            for (int j = 0; j < 4; ++j) { const int c = 4 * lane + 256 * j;
                if (YSRC) gatev[j] = *(const f32x4*)(P.gate + (size_t)rc * 6144 + P.gate_off + c);
                if (HOUT) { shiftv[j] = *(const f32x4*)(P.modh + (size_t)rc * 6144 + P.shift_off + c); scalev[j] = *(const f32x4*)(P.modh + (size_t)rc * 6144 + P.scale_off + c); } } }
        f32x4 x[4]; u32x2 ya[4], yb[4]; const float w0 = w0n, w1 = w1n;
#pragma unroll
        for (int j = 0; j < 4; ++j) { if (XI) x[j] = (f32x4){bf_lo(xnr[j].x), bf_hi(xnr[j].x), bf_lo(xnr[j].y), bf_hi(xnr[j].y)}; else x[j] = xn[j]; ya[j] = yan[j]; yb[j] = ybn[j]; }
#pragma unroll
        for (int j = 0; j < 4; ++j) { xn[j] = xm[j]; xnr[j] = xmr[j]; yan[j] = yam[j]; ybn[j] = ybm[j]; }
        w0n = w0m; w1n = w1m;
        if (row + 2 < r1) NP_LOAD(row + 2, xm, yam, ybm, w0m, w1m);
        if (row + 3 < r1) NP_TREC(row + 3);
        if (YSRC) {
            f32x4 y[4];
            if (YSRC == 1) {
#pragma unroll
                for (int j = 0; j < 4; ++j) y[j] = (f32x4){bf_lo(ya[j].x), bf_hi(ya[j].x), bf_lo(ya[j].y), bf_hi(ya[j].y)};
            } else {
#pragma unroll
                for (int j = 0; j < 4; ++j) y[j] = (f32x4){w0 * bf_lo(ya[j].x) + w1 * bf_lo(yb[j].x), w0 * bf_hi(ya[j].x) + w1 * bf_hi(yb[j].x), w0 * bf_lo(ya[j].y) + w1 * bf_lo(yb[j].y), w0 * bf_hi(ya[j].y) + w1 * bf_hi(yb[j].y)};
            }
            float ss = 0.f;
#pragma unroll
            for (int j = 0; j < 4; ++j) ss += (y[j].x * y[j].x + y[j].y * y[j].y) + (y[j].z * y[j].z + y[j].w * y[j].w);
            const float rs = 1.0f / sqrtf(wave_sum(ss) * (1.0f / D) + RMS_EPS);
#pragma unroll
            for (int j = 0; j < 4; ++j) { x[j] = x[j] + gatev[j] * (y[j] * rs * gAv[j]);
                if (XO) { bf16* xo = lat ? ((bf16*)P.xout_lat + (size_t)row * D) : ((bf16*)P.xout_ctx + (size_t)(row - TL) * D); u32x2 w; w.x = pk_bf16(x[j].x, x[j].y); w.y = pk_bf16(x[j].z, x[j].w); *(u32x2*)(xo + 4 * lane + 256 * j) = w;
                    x[j] = (f32x4){bf_lo(w.x), bf_hi(w.x), bf_lo(w.y), bf_hi(w.y)}; }
                else { float* xo = lat ? ((float*)P.xout_lat + (size_t)row * D) : ((float*)P.xout_ctx + (size_t)(row - TL) * D); *(f32x4*)(xo + 4 * lane + 256 * j) = x[j]; } }
        }
        if (HOUT) {
            float ss = 0.f;
#pragma unroll
            for (int j = 0; j < 4; ++j) ss += (x[j].x * x[j].x + x[j].y * x[j].y) + (x[j].z * x[j].z + x[j].w * x[j].w);
            const float rs = 1.0f / sqrtf(wave_sum(ss) * (1.0f / D) + RMS_EPS);
            f32x4 hv[4];
#pragma unroll
            for (int j = 0; j < 4; ++j) { hv[j] = (x[j] * rs * gBv[j]) * (1.0f + scalev[j]) + shiftv[j];
                if (H8 == 1) *(unsigned*)((unsigned char*)P.hout + (size_t)row * D + 4 * lane + 256 * j) = pk_fp8x4(hv[j].x, hv[j].y, hv[j].z, hv[j].w);
                if (H8 == 2) *(unsigned*)(P.hout8 + (size_t)row * D + 4 * lane + 256 * j) = pk_fp8x4(hv[j].x, hv[j].y, hv[j].z, hv[j].w);
                if (H8 != 1) { u32x2 w; w.x = pk_bf16(hv[j].x, hv[j].y); w.y = pk_bf16(hv[j].z, hv[j].w); *(u32x2*)(P.hout + (size_t)row * D + 4 * lane + 256 * j) = w; } }
            if (ROUTE) {
                float lg[8];
#pragma unroll
                for (int e = 0; e < 8; ++e) lg[e] = 0.f;
#pragma unroll
                for (int j = 0; j < 4; ++j)
#pragma unroll
                    for (int c = 0; c < 4; ++c) { const int col = 4 * lane + 256 * j + c; const f32x4 wa = *(const LAS f32x4*)(wr_lds + col * 8), wb = *(const LAS f32x4*)(wr_lds + col * 8 + 4); const float hh = hv[j][c];
                        lg[0] += hh * wa.x; lg[1] += hh * wa.y; lg[2] += hh * wa.z; lg[3] += hh * wa.w; lg[4] += hh * wb.x; lg[5] += hh * wb.y; lg[6] += hh * wb.z; lg[7] += hh * wb.w; }
#pragma unroll
                for (int e = 0; e < 8; ++e) lg[e] = wave_sum(lg[e]) + brt[e];
                int e0 = 0; float v0 = lg[0];
#pragma unroll
                for (int e = 1; e < 8; ++e) if (lg[e] > v0) { v0 = lg[e]; e0 = e; }
                int e1 = -1; float v1 = -3.0e38f;
#pragma unroll
                for (int e = 0; e < 8; ++e) if (e != e0 && lg[e] > v1) { v1 = lg[e]; e1 = e; }
                const float w0 = 1.0f / (1.0f + expf(v1 - v0)), w1 = 1.0f - w0;
                if (lane == 0) {
                    const int p0 = __hip_atomic_fetch_add(&lcnt[e0], 1, __ATOMIC_RELAXED, __HIP_MEMORY_SCOPE_WORKGROUP), p1 = __hip_atomic_fetch_add(&lcnt[e1], 1, __ATOMIC_RELAXED, __HIP_MEMORY_SCOPE_WORKGROUP);
                    LAS int* rr = rec + (F.wave * rpw + (row - r0)) * 8;
                    rr[0] = row; rr[1] = e0; rr[2] = p0; rr[3] = e1; rr[4] = p1; rr[5] = __float_as_int(w0); rr[6] = __float_as_int(w1);
                }
            }
        }
    }
#undef NP_LOAD
#undef NP_TREC
    if (ROUTE) {
        __syncthreads();
        if (F.tid < 8) lcnt[8 + F.tid] = (int)__hip_atomic_fetch_add(P.cursor + 64 * F.tid, (unsigned)lcnt[F.tid], RLX_AGENT);
        __syncthreads();
        for (int i = F.tid; i < 8 * rpw; i += 512) {
            const int w = i / rpw, k = i % rpw; const int wr0 = (F.vcu * 8 + w) * rpw; if (wr0 + k >= P.nrows) continue;
            const LAS int* rr = rec + i * 8; const int row = rr[0], e0 = rr[1], e1 = rr[3]; const int p0 = rr[2] + lcnt[8 + e0], p1 = rr[4] + lcnt[8 + e1];
            int* tr = (int*)(P.tokrec + (size_t)row * 32); tr[0] = e0; tr[1] = p0; tr[2] = e1; tr[3] = p1; tr[4] = rr[5]; tr[5] = rr[6];
            P.slottok[(size_t)e0 * TT + p0] = row; P.slottok[(size_t)e1 * TT + p1] = row;
        }
        __syncthreads();
    }
}

__device__ __forceinline__ int moe_tables(const Frame& F, const gu32* cursor, LAS int* ebase  , LAS int* tile_e  ) {
    __syncthreads();
    if (F.tid == 0) { int b = 0; for (int e = 0; e < 8; ++e) { const int c = (int)__hip_atomic_load(cursor + 64 * e, RLX_AGENT); ebase[e] = b; ebase[8 + e] = c; const int nt = (c + 255) >> 8; for (int t = 0; t < nt; ++t) if ((b >> 8) + t < MOE_MAXTILES) tile_e[(b >> 8) + t] = e; b += nt << 8; } ebase[16] = b >> 8; }
    __syncthreads();
    int nt = ebase[16]; return nt > MOE_MAXTILES ? MOE_MAXTILES : nt;
}

__device__ __forceinline__ void moe_gather(const Frame& F, const LAS int* ebase, int ntiles, const int* slottok, const bf16* hb, bf16* asort, bool f8) {
    const int gw = F.vcu * 8 + F.wave, NGW = F.G * 8, nslot = ntiles * 256;
    const size_t rb = f8 ? (size_t)D : (size_t)2 * D;
    for (int s0 = gw; s0 < nslot; s0 += 4 * NGW) {
        int tok[4]; bool ok[4];
#pragma unroll
        for (int k = 0; k < 4; ++k) { const int s = s0 + k * NGW; ok[k] = s < nslot; tok[k] = 0;
            if (ok[k]) { int e = 0;
#pragma unroll
                for (int q = 1; q < 8; ++q) e += (s >= ebase[q]) ? 1 : 0;
                const int pos = s - ebase[e]; ok[k] = pos < ebase[8 + e]; if (ok[k]) tok[k] = slottok[(size_t)e * TT + pos]; } }
        u32x4 a[4], b[4];
#pragma unroll
        for (int k = 0; k < 4; ++k) if (ok[k]) { const u32x4* src = (const u32x4*)((const unsigned char*)hb + (size_t)tok[k] * rb); a[k] = src[F.lane]; if (!f8) b[k] = src[64 + F.lane]; }
#pragma unroll
        for (int k = 0; k < 4; ++k) if (ok[k]) { u32x4* dst = (u32x4*)((unsigned char*)asort + (size_t)(s0 + k * NGW) * rb); dst[F.lane] = a[k]; if (!f8) dst[64 + F.lane] = b[k]; }
    }
}

constexpr int KS_PITCH = 144, ATT_KB = 64 * KS_PITCH, ATT_BUF = 2 * ATT_KB;
typedef short v4i16_t __attribute__((ext_vector_type(4)));
__device__ __forceinline__ int crow(int i, int h) { return (i & 3) + 8 * (i >> 2) + 4 * h; }
__device__ __forceinline__ bf16x8 pack8(const f32x16& x, int s) {
    u32x4 p; p.x = pk_bf16(x[8 * s + 0], x[8 * s + 1]); p.y = pk_bf16(x[8 * s + 2], x[8 * s + 3]); p.z = pk_bf16(x[8 * s + 4], x[8 * s + 5]); p.w = pk_bf16(x[8 * s + 6], x[8 * s + 7]);
    return __builtin_bit_cast(bf16x8, p);
}
#define MFMA32(a, b, c) __builtin_amdgcn_mfma_f32_32x32x16_bf16((a), (b), (c), 0, 0, 0)
__device__ __forceinline__ void attn_unit(const Frame& F, int unit, const bf16* QB, const bf16* KB, const bf16* VB, bf16* AO, const float* sink_l) {
    const int tid = F.tid, wid = F.wave, lane = F.lane, r = lane & 31, h = lane >> 5;
    const bool isctx = unit >= 512;
    int b, kvh, nb;
    if (!isctx) { b = unit >> 6; kvh = (unit >> 5) & 1; nb = unit & 31; } else { const int v = unit - 512; b = v >> 2; kvh = (v >> 1) & 1; nb = v & 1; }
    const int qtok0 = isctx ? (TL + b * CTXL + nb * 128) : (b * SEQ + nb * 128);
    const int ctxtok0 = TL + b * CTXL;
    const int hq = kvh * 4 + (wid >> 1);
    const int qrow0 = (wid & 1) * 64;
    bf16x8 qf[2][4];
#pragma unroll
    for (int qb = 0; qb < 2; ++qb)
#pragma unroll
        for (int ks = 0; ks < 4; ++ks) qf[qb][ks] = *(const bf16x8*)(QB + (size_t)(qtok0 + qrow0 + qb * 32 + r) * DATT + hq * 64 + ks * 16 + 8 * h);
    const float sinkv = sink_l[hq] * LOG2E;
    float m_[2] = {sinkv, sinkv}, l_[2]; l_[0] = l_[1] = (h == 0) ? 1.0f : 0.0f;
    f32x16 o[2][2];
#pragma unroll
    for (int i = 0; i < 16; ++i) { o[0][0][i] = 0.f; o[0][1][i] = 0.f; o[1][0][i] = 0.f; o[1][1][i] = 0.f; }
    const int lo = isctx ? 0 : (nb == 0 ? 2 : 0), hi = isctx ? 0 : (nb == 31 ? 4 : 6), total = (hi - lo) + 4;
    const int skey = tid >> 3, sch = tid & 7;
    u32x4 kreg, vreg;
    auto tile_tok = [&](int idx) -> int { const int tt = lo + idx; return (tt >= hi) ? (ctxtok0 + 64 * (tt - hi)) : (b * SEQ + (nb - 1) * 128 + 64 * tt); };
    { const int kt = tile_tok(0); kreg = *(const u32x4*)(KB + (size_t)(kt + skey) * DKV + kvh * 64 + sch * 8); vreg = *(const u32x4*)(VB + (size_t)(kt + skey) * DKV + kvh * 64 + sch * 8); }
    auto stage_write = [&](int buf) {
        LAS unsigned char* kb_ = F.lds + buf * ATT_BUF; LAS unsigned char* vb_ = kb_ + ATT_KB;
        *(LAS u32x4*)(kb_ + skey * KS_PITCH + sch * 16) = kreg;
        *(LAS u32x4*)(vb_ + skey * KS_PITCH + sch * 16) = vreg;
    };
    __syncthreads();
    stage_write(0);
    __syncthreads();
    for (int idx = 0; idx < total; ++idx) {
        const int tt = lo + idx, buf = idx & 1;
        if (idx + 1 < total) { const int kt = tile_tok(idx + 1); kreg = *(const u32x4*)(KB + (size_t)(kt + skey) * DKV + kvh * 64 + sch * 8); vreg = *(const u32x4*)(VB + (size_t)(kt + skey) * DKV + kvh * 64 + sch * 8); }
        const LAS unsigned char* kbuf = F.lds + buf * ATT_BUF; const LAS unsigned char* vbuf = kbuf + ATT_KB;
        const int mtype = (tt < hi) ? (tt < 2 ? 1 : (tt >= 4 ? 2 : 0)) : 0;
        bf16x8 kf[2][4];
#pragma unroll
        for (int kb = 0; kb < 2; ++kb)
#pragma unroll
            for (int ks = 0; ks < 4; ++ks) kf[kb][ks] = *(const LAS bf16x8*)(kbuf + (32 * kb + r) * KS_PITCH + (16 * ks + 8 * h) * 2);
        bf16x8 pk[2][2][2];
#pragma unroll
        for (int qb = 0; qb < 2; ++qb) {
            f32x16 s[2];
            const float nref = -m_[qb];
#pragma unroll
            for (int i = 0; i < 16; ++i) { s[0][i] = nref; s[1][i] = nref; }
#pragma unroll
            for (int ks = 0; ks < 4; ++ks) { s[0] = MFMA32(kf[0][ks], qf[qb][ks], s[0]); s[1] = MFMA32(kf[1][ks], qf[qb][ks], s[1]); }
            const int iq = qrow0 + 32 * qb + r;
            float ls = 0.f;
            if (mtype == 1) {
                asm volatile("");
                const int thr = iq - 64 * tt - 4 * h;
#pragma unroll
                for (int kb = 0; kb < 2; ++kb)
#pragma unroll
                    for (int i = 0; i < 16; ++i) { const float p = (32 * kb + (i & 3) + 8 * (i >> 2) >= thr) ? fast_exp2(s[kb][i]) : 0.f; s[kb][i] = p; ls += p; }
            } else if (mtype == 2) {
                asm volatile("");
                const int thr = iq - 64 * (tt - 4) - 4 * h;
#pragma unroll
                for (int kb = 0; kb < 2; ++kb)
#pragma unroll
                    for (int i = 0; i < 16; ++i) { const float p = (32 * kb + (i & 3) + 8 * (i >> 2) <= thr) ? fast_exp2(s[kb][i]) : 0.f; s[kb][i] = p; ls += p; }
            } else {
#pragma unroll
                for (int kb = 0; kb < 2; ++kb)
#pragma unroll
                    for (int i = 0; i < 16; ++i) { const float p = fast_exp2(s[kb][i]); s[kb][i] = p; ls += p; }
            }
            l_[qb] += ls;
#pragma unroll
            for (int kb = 0; kb < 2; ++kb) { pk[qb][kb][0] = pack8(s[kb], 0); pk[qb][kb][1] = pack8(s[kb], 1); }
        }
#pragma unroll
        for (int kb = 0; kb < 2; ++kb)
#pragma unroll
            for (int st = 0; st < 2; ++st)
#pragma unroll
                for (int db = 0; db < 2; ++db) {
                    const LAS unsigned char* vp = vbuf + (32 * kb + 16 * st + 4 * h + ((lane & 15) >> 2)) * KS_PITCH + (32 * db + 16 * ((lane >> 4) & 1) + 4 * (lane & 3)) * 2;
                    const s16x4 vlo = __builtin_bit_cast(s16x4, __builtin_amdgcn_ds_read_tr16_b64_v4i16((LAS v4i16_t*)vp));
                    const s16x4 vhi = __builtin_bit_cast(s16x4, __builtin_amdgcn_ds_read_tr16_b64_v4i16((LAS v4i16_t*)(vp + 8 * KS_PITCH)));
                    const bf16x8 vf = __builtin_shufflevector(vlo, vhi, 0, 1, 2, 3, 4, 5, 6, 7);
                    o[db][0] = MFMA32(vf, pk[0][kb][st], o[db][0]); o[db][1] = MFMA32(vf, pk[1][kb][st], o[db][1]);
                }
        if (idx + 1 < total) stage_write(buf ^ 1);
        __syncthreads();
    }
#pragma unroll
    for (int qb = 0; qb < 2; ++qb) {
        const float lt = l_[qb] + __int_as_float(__builtin_amdgcn_ds_bpermute((F.lane ^ 32) << 2, __float_as_int(l_[qb]))); const float inv = 1.0f / lt;
        bf16* orow = AO + (size_t)(qtok0 + qrow0 + qb * 32 + r) * DATT + hq * 64;
#pragma unroll
        for (int db = 0; db < 2; ++db)
#pragma unroll
            for (int g4 = 0; g4 < 4; ++g4) { u32x2 w; w.x = pk_bf16(o[db][qb][4 * g4] * inv, o[db][qb][4 * g4 + 1] * inv); w.y = pk_bf16(o[db][qb][4 * g4 + 2] * inv, o[db][qb][4 * g4 + 3] * inv);
                *(u32x2*)(orow + 32 * db + 8 * g4 + 4 * h) = w; }
    }
}

__device__ __forceinline__ void ssm_carry(const Frame& F, int l) {
    const f32x2* powt = (const f32x2*)(WSP() + WS_POW); const float* ef = (const float*)(WSP() + WS_EF); bf16* ag = (bf16*)(WSP() + WS_AG);
    LAS f32x2* tot = (LAS f32x2*)F.lds;
    const int p = F.lane;
    for (int bg = F.vcu; bg < NB * NG; bg += F.G) {
        const int b = bg >> 5, g = bg & 31, rowb = g * SSM_RPAD + b * NCHUNK, seg = F.wave;
        f32x2 lin[2][17]; f32x2 lam32[2];
#define CARRY_C(dir, step) (((dir) == 0) ? (step) : ((step) < 8 ? 7 - (step) : 143 - (step)))
        __syncthreads();
#pragma unroll
        for (int dir = 0; dir < 2; ++dir) {
            const f32x2 lam = powt[(size_t)(((l * 2 + dir) * 32 + g) * 64 + p) * 33 + 32]; lam32[dir] = lam;
            f32x2 e[17];
#pragma unroll
            for (int k = 0; k < 17; ++k) e[k] = *(const f32x2*)(ef + (size_t)(rowb + CARRY_C(dir, seg * 17 + k)) * 256 + dir * 128 + 2 * p);
            float sr = 0.f, si = 0.f;
#pragma unroll
            for (int k = 0; k < 17; ++k) { lin[dir][k] = (f32x2){sr, si}; const float nr = lam.x * sr - lam.y * si + e[k].x, ni = lam.x * si + lam.y * sr + e[k].y; sr = nr; si = ni; }
            tot[(dir * 8 + seg) * 64 + p] = (f32x2){sr, si};
        }
        __syncthreads();
#pragma unroll
        for (int dir = 0; dir < 2; ++dir) {
            const f32x2 lam = lam32[dir];
            f32x2 A = (f32x2){1.f, 0.f};
#pragma unroll
            for (int k = 0; k < 17; ++k) A = (f32x2){A.x * lam.x - A.y * lam.y, A.x * lam.y + A.y * lam.x};
            float sr = 0.f, si = 0.f;
            for (int s2 = 0; s2 < seg; ++s2) { const f32x2 t = tot[(dir * 8 + s2) * 64 + p]; const float nr = A.x * sr - A.y * si + t.x, ni = A.x * si + A.y * sr + t.y; sr = nr; si = ni; }
            float mr = 1.f, mi = 0.f;
#pragma unroll
            for (int k = 0; k < 17; ++k) {
                const float vr = lin[dir][k].x + (mr * sr - mi * si), vi = lin[dir][k].y + (mr * si + mi * sr);
                *(unsigned*)(ag + (size_t)(rowb + CARRY_C(dir, seg * 17 + k)) * AG_PITCH + 512 + dir * 128 + 2 * p) = pk_bf16(vr, vi);
                const float nr = mr * lam.x - mi * lam.y, ni = mr * lam.y + mi * lam.x; mr = nr; mi = ni; }
        }
#undef CARRY_C
    }
    gen_bty(F, l, F.vcu * 512 + F.tid, F.G * 512);
}

struct OpsDense { int K, lda, ldb; const char* A; const char* B; int wscale;
    __device__ __forceinline__ unsigned a_off(const Unit& u) const { return (unsigned)u.pm * 256u * (unsigned)lda; }
    __device__ __forceinline__ unsigned b_off(const Unit& u) const { return (unsigned)u.pn * 256u * (unsigned)ldb; } };
struct OpsGroup { int K, lda, ldb; const char* A; const char* B; size_t a_g, b_g; int wscale;
    __device__ __forceinline__ unsigned a_off(const Unit& u) const { return (unsigned)u.g * (unsigned)a_g + (unsigned)u.pm * 256u * (unsigned)lda; }
    __device__ __forceinline__ unsigned b_off(const Unit& u) const { return (unsigned)u.g * (unsigned)b_g + (unsigned)u.pn * 256u * (unsigned)ldb; } };
struct OpsMoe { int K, lda, ldb; const char* A; const char* B; size_t b_g; int wscale;
    __device__ __forceinline__ unsigned a_off(const Unit& u) const { return (unsigned)u.pm * 256u * (unsigned)lda; }
    __device__ __forceinline__ unsigned b_off(const Unit& u) const { return (unsigned)u.g * (unsigned)b_g + (unsigned)u.pn * 256u * (unsigned)ldb; } };

typedef const f32x4 (&AccRef)[2][2][4][2];
#define EPI_ROWS(ai, m) (u.pm * 256 + (ai) * 128 + wr * 64 + (m) * 16 + fr)
__device__ __forceinline__ u32x4 pack_row8(const f32x4& v0, const f32x4& v1) { u32x4 w; w.x = pk_bf16(v0[0], v0[1]); w.y = pk_bf16(v0[2], v0[3]); w.z = pk_bf16(v1[0], v1[1]); w.w = pk_bf16(v1[2], v1[3]); return w; }
__device__ __forceinline__ void unpack8(const u32x4& w, f32x4& a, f32x4& b) { a = (f32x4){bf_lo(w.x), bf_hi(w.x), bf_lo(w.y), bf_hi(w.y)}; b = (f32x4){bf_lo(w.z), bf_hi(w.z), bf_lo(w.w), bf_hi(w.w)}; }
#ifndef EPI_WT
#define EPI_WT 0
#endif
__device__ __forceinline__ void st16(void* base, unsigned off, const u32x4& v) {
#if EPI_WT
    asm volatile("global_store_dwordx4 %0, %1, %2 sc1\n\ts_nop 1" :: "v"(off), "v"(v), "s"(base) : "memory");
#else
    *(u32x4*)((char*)base + off) = v;
#endif
}
__device__ __forceinline__ void st16f(void* base, unsigned off, const f32x4& v) { *(f32x4*)((char*)base + off) = v; }
__device__ __forceinline__ u32x4 ld16(const void* base, unsigned off) { return *(const u32x4*)((const char*)base + off); }
__device__ __forceinline__ f32x4 ld16f(const void* base, unsigned off) { return *(const f32x4*)((const char*)base + off); }

struct EpiIn {
    static constexpr bool PERM = true;
    bf16 *QB, *KB, *VB, *AG; const float* ropec; const float* ropes;
    __device__ __forceinline__ void operator()(AccRef acc, const Unit& u, int wr, int wc, int fr, int fq) const {
        const unsigned cq = wc * 32 + 8 * fq; const bool lat = u.pm < 128;
#define ROPE8(v0, v1, cc, ss) do { const f32x4 a0_ = v0, a1_ = v1; \
            v0[0] = a0_[0] * cc[0] - a0_[1] * ss[0]; v0[1] = a0_[1] * cc[0] + a0_[0] * ss[0]; v0[2] = a0_[2] * cc[1] - a0_[3] * ss[1]; v0[3] = a0_[3] * cc[1] + a0_[2] * ss[1]; \
            v1[0] = a1_[0] * cc[2] - a1_[1] * ss[2]; v1[1] = a1_[1] * cc[2] + a1_[0] * ss[2]; v1[2] = a1_[2] * cc[3] - a1_[3] * ss[3]; v1[3] = a1_[3] * cc[3] + a1_[2] * ss[3]; } while (0)
        if (u.pn <= 1) {
#pragma unroll
            for (int ai = 0; ai < 2; ++ai) {
                f32x4 c4[4][2], s4[4][2];
                if (lat) {
#pragma unroll
                    for (int m = 0; m < 4; ++m)
#pragma unroll
                        for (int bj = 0; bj < 2; ++bj) { const unsigned col = u.pn * 256 + bj * 128 + cq; const unsigned roff = ((((unsigned)EPI_ROWS(ai, m)) & 4095u) * 32 + ((col & 63u) >> 1)) * 4; c4[m][bj] = ld16f(ropec, roff); s4[m][bj] = ld16f(ropes, roff); }
                } else {
#pragma unroll
                    for (int m = 0; m < 4; ++m)
#pragma unroll
                        for (int bj = 0; bj < 2; ++bj) { c4[m][bj] = (f32x4){1.f, 1.f, 1.f, 1.f}; s4[m][bj] = (f32x4){0.f, 0.f, 0.f, 0.f}; }
                }
#pragma unroll
                for (int m = 0; m < 4; ++m)
#pragma unroll
                    for (int bj = 0; bj < 2; ++bj) { f32x4 v0 = acc[ai][bj][m][0], v1 = acc[ai][bj][m][1]; ROPE8(v0, v1, c4[m][bj], s4[m][bj]); v0 = v0 * QSCALE; v1 = v1 * QSCALE;
                        st16(QB, ((unsigned)EPI_ROWS(ai, m) * DATT + u.pn * 256 + bj * 128 + cq) * 2, pack_row8(v0, v1)); }
            }
        } else if (u.pn == 2) {
#pragma unroll
            for (int ai = 0; ai < 2; ++ai) {
                f32x4 c4[4], s4[4];
                if (lat) {
#pragma unroll
                    for (int m = 0; m < 4; ++m) { const unsigned roff = ((((unsigned)EPI_ROWS(ai, m)) & 4095u) * 32 + ((cq & 63u) >> 1)) * 4; c4[m] = ld16f(ropec, roff); s4[m] = ld16f(ropes, roff); }
                } else {
#pragma unroll
                    for (int m = 0; m < 4; ++m) { c4[m] = (f32x4){1.f, 1.f, 1.f, 1.f}; s4[m] = (f32x4){0.f, 0.f, 0.f, 0.f}; }
                }
#pragma unroll
                for (int m = 0; m < 4; ++m) { const unsigned tok = EPI_ROWS(ai, m);
                    f32x4 v0 = acc[ai][0][m][0], v1 = acc[ai][0][m][1]; ROPE8(v0, v1, c4[m], s4[m]);
                    st16(KB, (tok * DKV + cq) * 2, pack_row8(v0, v1));
                    st16(VB, (tok * DKV + cq) * 2, pack_row8(acc[ai][1][m][0], acc[ai][1][m][1])); }
            }
#undef ROPE8
        } else {
#pragma unroll
            for (int ai = 0; ai < 2; ++ai)
#pragma unroll
                for (int m = 0; m < 4; ++m) { const unsigned tok = EPI_ROWS(ai, m); unsigned rowag, ii;
                    if (lat) { const unsigned b = tok >> 12, t = tok & 4095u; rowag = b * NCHUNK + 8 + (t >> 5); ii = t & 31u; } else { const unsigned tc = tok - TL, b = tc >> 8, t = tc & 255u; rowag = b * NCHUNK + (t >> 5); ii = t & 31u; }
#pragma unroll
                    for (int bj = 0; bj < 2; ++bj) { const unsigned cu = (u.pn - 3) * 256 + bj * 128 + cq, g = cu >> 4, h0 = cu & 15u;
                        st16(AG, ((g * SSM_RPAD + rowag) * AG_PITCH + ii * 16 + h0) * 2, pack_row8(acc[ai][bj][m][0], acc[ai][bj][m][1])); } }
        }
    }
};
struct EpiGate {
    static constexpr bool PERM = true;
    bf16 *SGA, *SGB;
    __device__ __forceinline__ void operator()(AccRef acc, const Unit& u, int wr, int wc, int fr, int fq) const {
        bf16* base = (u.pn < 4) ? SGA : SGB; const unsigned c0 = (u.pn & 3) * 256 + wc * 32 + 8 * fq;
#pragma unroll
        for (int ai = 0; ai < 2; ++ai)
#pragma unroll
            for (int m = 0; m < 4; ++m) { const unsigned tok = EPI_ROWS(ai, m);
#pragma unroll
                for (int bj = 0; bj < 2; ++bj) { f32x4 v0 = acc[ai][bj][m][0], v1 = acc[ai][bj][m][1];
                    v0 = sigmoid4(v0); v1 = sigmoid4(v1);
                    st16(base, (tok * D + c0 + bj * 128) * 2, pack_row8(v0, v1)); } }
    }
};
struct EpiE {
    static constexpr bool PERM = false;
    float* EF;
    __device__ __forceinline__ void operator()(AccRef acc, const Unit& u, int wr, int wc, int fr, int fq) const {
#pragma unroll
        for (int ai = 0; ai < 2; ++ai)
#pragma unroll
            for (int m = 0; m < 4; ++m) { const unsigned ro = ((unsigned)(u.g * SSM_RPAD + EPI_ROWS(ai, m)) * 256 + wc * 32 + 4 * fq) * 4;
#pragma unroll
                for (int bj = 0; bj < 2; ++bj)
#pragma unroll
                    for (int n = 0; n < 2; ++n) st16f(EF, ro + (bj * 128 + n * 16) * 4, acc[ai][bj][m][n]); }
    }
};
struct EpiY {
    static constexpr bool PERM = true;
    bf16* GY;
    __device__ __forceinline__ void operator()(AccRef acc, const Unit& u, int wr, int wc, int fr, int fq) const {
#pragma unroll
        for (int ai = 0; ai < 2; ++ai)
#pragma unroll
            for (int m = 0; m < 4; ++m) { const unsigned rr = EPI_ROWS(ai, m); if (rr >= (unsigned)SSM_ROWS) continue; const unsigned b = rr / NCHUNK, c = rr % NCHUNK;
                const unsigned tokb = (c < 8) ? (TL + b * CTXL + c * 32) : (b * SEQ + (c - 8) * 32);
#pragma unroll
                for (int bj = 0; bj < 2; ++bj) { const unsigned col = u.pn * 256 + bj * 128 + wc * 32 + 8 * fq, ii = col >> 4, h0 = col & 15u; f32x4 v0 = acc[ai][bj][m][0], v1 = acc[ai][bj][m][1];
                    v0 = gelu4(v0); v1 = gelu4(v1);
                    st16(GY, ((tokb + ii) * DSSM + u.g * 16 + h0) * 2, pack_row8(v0, v1)); } }
    }
};
struct EpiGlu {
    static constexpr bool PERM = true;
    const bf16* GY; bf16* SB; const float* bias;
    __device__ __forceinline__ void operator()(AccRef acc, const Unit& u, int wr, int wc, int fr, int fq) const {
        f32x4 b0[2], b1[2];
#pragma unroll
        for (int bj = 0; bj < 2; ++bj) { const unsigned col = u.pn * 256 + bj * 128 + wc * 32 + 8 * fq; b0[bj] = ld16f(bias, col * 4); b1[bj] = ld16f(bias, col * 4 + 16); }
        u32x4 gy[2][4][2]; unsigned off[2][4][2];
#pragma unroll
        for (int ai = 0; ai < 2; ++ai)
#pragma unroll
            for (int m = 0; m < 4; ++m)
#pragma unroll
                for (int bj = 0; bj < 2; ++bj) { off[ai][m][bj] = ((unsigned)EPI_ROWS(ai, m) * DSSM + u.pn * 256 + bj * 128 + wc * 32 + 8 * fq) * 2; gy[ai][m][bj] = ld16(GY, off[ai][m][bj]); }
#pragma unroll
        for (int ai = 0; ai < 2; ++ai)
#pragma unroll
            for (int m = 0; m < 4; ++m)
#pragma unroll
                for (int bj = 0; bj < 2; ++bj) { f32x4 g0, g1; unpack8(gy[ai][m][bj], g0, g1);
                    f32x4 v0 = acc[ai][bj][m][0] + b0[bj], v1 = acc[ai][bj][m][1] + b1[bj];
                    v0 = g0 * sigmoid4(v0); v1 = g1 * sigmoid4(v1);
                    st16(SB, off[ai][m][bj], pack_row8(v0, v1)); }
    }
};
template <int MODE> struct EpiMerge {
    static constexpr bool PERM = true;
    const bf16* SG; const bf16* MIN; bf16* MB;
    __device__ __forceinline__ void operator()(AccRef acc, const Unit& u, int wr, int wc, int fr, int fq) const {
        u32x4 sg[2][4][2], mn[4][2]; unsigned off[2][4][2];
#pragma unroll
        for (int ai = 0; ai < 2; ++ai)
#pragma unroll
            for (int m = 0; m < 4; ++m)
#pragma unroll
                for (int bj = 0; bj < 2; ++bj) { off[ai][m][bj] = ((unsigned)EPI_ROWS(ai, m) * D + u.pn * 256 + bj * 128 + wc * 32 + 8 * fq) * 2; sg[ai][m][bj] = ld16(SG, off[ai][m][bj]); }
        if (MODE == 1) {
#pragma unroll
            for (int m = 0; m < 4; ++m)
#pragma unroll
                for (int bj = 0; bj < 2; ++bj) mn[m][bj] = ld16(MIN, off[0][m][bj]); }
#pragma unroll
        for (int ai = 0; ai < 2; ++ai) {
            u32x4 outv[4][2];
#pragma unroll
            for (int m = 0; m < 4; ++m)
#pragma unroll
                for (int bj = 0; bj < 2; ++bj) { f32x4 g0, g1; unpack8(sg[ai][m][bj], g0, g1);
                    f32x4 v0 = g0 * acc[ai][bj][m][0], v1 = g1 * acc[ai][bj][m][1];
                    if (MODE == 1) { f32x4 p0, p1; unpack8(mn[m][bj], p0, p1); v0 = v0 + p0; v1 = v1 + p1; }
                    outv[m][bj] = pack_row8(v0, v1); }
            if (MODE == 1 && ai == 0) {
#pragma unroll
                for (int m = 0; m < 4; ++m)
#pragma unroll
                    for (int bj = 0; bj < 2; ++bj) mn[m][bj] = ld16(MIN, off[1][m][bj]); }
#pragma unroll
            for (int m = 0; m < 4; ++m)
#pragma unroll
                for (int bj = 0; bj < 2; ++bj) st16(MB, off[ai][m][bj], outv[m][bj]);
        }
    }
};
struct EpiStore {
    static constexpr bool PERM = true;
    bf16* O; int ldc;
    __device__ __forceinline__ void operator()(AccRef acc, const Unit& u, int wr, int wc, int fr, int fq) const {
#pragma unroll
        for (int ai = 0; ai < 2; ++ai)
#pragma unroll
            for (int m = 0; m < 4; ++m)
#pragma unroll
                for (int bj = 0; bj < 2; ++bj) st16(O, ((unsigned)EPI_ROWS(ai, m) * ldc + u.pn * 256 + bj * 128 + wc * 32 + 8 * fq) * 2, pack_row8(acc[ai][bj][m][0], acc[ai][bj][m][1]));
    }
};
template <bool O8> struct EpiSwiglu {
    static constexpr bool PERM = true;
    unsigned char* O; int ldc; int t0;
    __device__ __forceinline__ void operator()(AccRef acc, const Unit& u, int wr, int wc, int fr, int fq) const {
#pragma unroll
        for (int ai = 0; ai < 2; ++ai)
#pragma unroll
            for (int m = 0; m < 4; ++m) { f32x4 v0 = acc[ai][0][m][0], v1 = acc[ai][0][m][1];
                v0 = (v0 * acc[ai][1][m][0]) * sigmoid4(v0); v1 = (v1 * acc[ai][1][m][1]) * sigmoid4(v1);
                const unsigned eo = (unsigned)(EPI_ROWS(ai, m) - 256 * t0) * (unsigned)ldc + u.pn * 128 + wc * 32 + 8 * fq;
                if (O8) { u32x2 w; w.x = pk_fp8x4_nc(v0[0], v0[1], v0[2], v0[3]); w.y = pk_fp8x4_nc(v1[0], v1[1], v1[2], v1[3]); *(u32x2*)(O + eo) = w; }
                else st16(O, eo * 2, pack_row8(v0, v1)); }
    }
};

__global__ void __launch_bounds__(512, 2) hybrid_fwd(Args args) {
    extern __shared__ __attribute__((aligned(16))) unsigned char lds_raw[];
    Frame F0;
#define F F0
    F.lds = (LAS unsigned char*)lds_raw;
    F.tid = threadIdx.x; F.lane = F.tid & 63; F.wave = __builtin_amdgcn_readfirstlane(F.tid >> 6);
    F.G = gridDim.x; { const int bx = blockIdx.x; F.vcu = (F.G % 8 == 0) ? (bx % 8) * (F.G / 8) + bx / 8 : bx; }
    volatile LAS unsigned* MISC = (volatile LAS unsigned*)(F.lds + MISC_OFF);
    for (int u = F.tid; u < 64; u += 512) MISC[u] = 0u;
    if (F.tid == 0) { volatile LAS unsigned long long* pt = (volatile LAS unsigned long long*)(F.lds + PTAB_OFF);
#pragma unroll
        for (int i = 0; i < 30; ++i) pt[i] = (unsigned long long)args.in[i];
        pt[30] = (unsigned long long)args.out; pt[31] = (unsigned long long)args.ws; }
    __syncthreads();
    { const XcdBarrier bar0 = xcd_barrier_post((unsigned*)(CTLP() + CW_BAR), MISC + 8); if (F.tid == 0) MISC[10] = bar0.x; }
    __syncthreads();
#define GRID_BAR() do { XcdBarrier b_; b_.bar = (unsigned*)((gu32*)((GAS unsigned char*)ptab_get(F0, 31) + WS_CTL) + CW_BAR); b_.x = MISC[10]; b_.st = MISC + 8; xcd_barrier(b_, F0.wave == 0 && ((__builtin_amdgcn_mbcnt_hi(~0u, __builtin_amdgcn_mbcnt_lo(~0u, 0u)) & 63u) == 0u)); } while (0)
    LAS int* tab_ebase = (LAS int*)(F.lds + TAB_OFF);
    LAS int* tab_tile = (LAS int*)(F.lds + TAB_OFF + 128);
    const int bid = (int)blockIdx.x;
#define ws WSP()
#define modb ((float*)(WSP() + WS_MOD))
#define HB ((bf16*)(WSP() + WS_HB))
#define XC ((float*)(WSP() + WS_XC))

#undef F
    { const Frame F = relaunder(F0);
    PH(0) mod_sc_init(F);
    RPT(1) { if (rep_) GRID_BAR(); PH(1) p0_tables(F); }
    RPT(2) { if (rep_) GRID_BAR(); PH(2) p0_weights(F); }
    }
    GRID_BAR();
    { const Frame F = relaunder(F0);
    RPT(3) { if (rep_) GRID_BAR(); PH(3) p1_kfull(F); }
    PH(0) mod_combine(F);
    }
    GRID_BAR();
    { const Frame F = relaunder(F0);
    RPT(4) { if (rep_) GRID_BAR(); PH(4) {
        NpArgs P{}; P.xin_lat = INP(I_X); P.xin_ctx = INP(I_CTX); P.xout_lat = OUTP(); P.xout_ctx = XC;
        P.gB = INP(I_NORMG) + (0 * 4 + 0) * D; P.modh = modb; P.shift_off = 0; P.scale_off = 1024; P.hout = HB; P.hout8 = ws + WS_H8; P.nrows = TT;
        norm_pass<0, true, false, 2, false, false>(F, P);
    } }
    }
    GRID_BAR();

    for (int l = 0; l < DEPTH; ++l) {
        const bool last = (l == DEPTH - 1);
        const bool f8 = (F8MASK >> l) & 1u;
        const int nM = last ? 128 : 136;

        { const Frame F = relaunder(F0);
            {
                OpsDense O{2 * D, 2 * D, 2 * D, (const char*)HB, (const char*)(ws + WS_WIN + (size_t)l * WIN_L), 0};
                pg8::DenseOrder S; S.init(136, 5, F.G, bid);
                EpiIn E{(bf16*)(ws + WS_QB), (bf16*)(ws + WS_KB), (bf16*)(ws + WS_VB), (bf16*)(ws + WS_AG), (const float*)(ws + WS_ROPE), (const float*)(ws + WS_ROPE) + 4096 * 32};
                RPT(5) { if (rep_) GRID_BAR(); PH(5) pg8::gemm_phase<0>(F.lds, F.wave, O, S, E); }
            }
            {
                OpsDense O{D, D, D, (const char*)(ws + WS_H8), (const char*)(ws + WS_WIN + (size_t)l * WIN_L + (size_t)NQKVU * D * 2), 0};
                pg8::DenseOrder S; S.init(136, 8, F.G, (bid + 88) % F.G);
                EpiGate E{(bf16*)(ws + WS_SGA), (bf16*)(ws + WS_SGB)};
                RPT(5) { if (rep_) GRID_BAR(); PH(5) pg8::gemm_phase<124>(F.lds, F.wave, O, S, E); }
            }
            RPT(6) { if (rep_) GRID_BAR(); PH(6) gen_w1(F, l); }
        }
        GRID_BAR();
        { const Frame F = relaunder(F0);
            OpsGroup O{1024, 2 * AG_PITCH, 1024, (const char*)(ws + WS_AG), (const char*)(ws + WS_W1), (size_t)SSM_RPAD * AG_PITCH * 2, (size_t)256 * 512 * 2, 0};
            pg8::GroupOrder S; S.init(NG, 5, 1, F.G, bid);
            EpiE E{(float*)(ws + WS_EF)};
            RPT(7) { if (rep_) GRID_BAR(); PH(7) pg8::gemm_phase<0>(F.lds, F.wave, O, S, E); }
            const int nunits = last ? 512 : 544;
            RPT(8) { if (rep_) GRID_BAR();
            gu32* qctr = CTLP() + CW_QUEUE + 64 * (l + 4 * rep_);
            for (;;) {
                __syncthreads();
                if (F.tid == 0) MISC[16] = __hip_atomic_fetch_add(qctr, 1u, RLX_AGENT);
                __syncthreads();
                const int unit = __builtin_amdgcn_readfirstlane((int)MISC[16]);
                if (unit >= nunits) break;
                PH(8) attn_unit(F, unit, (const bf16*)(ws + WS_QB), (const bf16*)(ws + WS_KB), (const bf16*)(ws + WS_VB), (bf16*)(ws + WS_AO), INP(I_SINK) + l * 8);
            }
            }
            bg_tail(F, l * 16 + 9, true, true, F.G, l >> 1);
        }
        GRID_BAR();
        { const Frame F = relaunder(F0); RPT(9) { if (rep_) GRID_BAR(); PH(9) ssm_carry(F, l); } }
        GRID_BAR();
        { const Frame F = relaunder(F0);
            OpsGroup O{1536, 2 * AG_PITCH, 1536, (const char*)(ws + WS_AG), (const char*)(ws + WS_BTY), (size_t)SSM_RPAD * AG_PITCH * 2, (size_t)512 * 768 * 2, 0};
            pg8::GroupOrder S; S.init(NG, 5, 2, F.G, bid);
            EpiY E{(bf16*)(ws + WS_GY)};
            RPT(10) { if (rep_) GRID_BAR(); PH(10) pg8::gemm_phase<0>(F.lds, F.wave, O, S, E); }
        }
        { const Frame F = relaunder(F0);
            OpsDense O{1024, 1024, 1024, (const char*)(ws + WS_AO), (const char*)(ws + WS_WPA + (size_t)l * 1024 * 512 * 2), 0};
            pg8::DenseOrder S; S.init(nM, 4, F.G, bid, 1);
            EpiMerge<0> E{(const bf16*)(ws + WS_SGA), nullptr, (bf16*)(ws + WS_HB)};
            RPT(11) { if (rep_) GRID_BAR(); PH(11) pg8::gemm_phase<0>(F.lds, F.wave, O, S, E); }
        }
        GRID_BAR();
        { const Frame F = relaunder(F0);
            OpsDense O{1024, 1024, 1024, (const char*)(ws + WS_GY), (const char*)(ws + WS_WGLU + (size_t)l * 512 * 512 * 2), 0};
            pg8::DenseOrder S; S.init(nM, 2, F.G, bid);
            EpiGlu E{(const bf16*)(ws + WS_GY), (bf16*)(ws + WS_SB), INP(I_BGLU) + l * 512};
            RPT(12) { if (rep_) GRID_BAR(); PH(12) pg8::gemm_phase<0>(F.lds, F.wave, O, S, E); }
            bg_tail(F, l * 16 + 0, !S.slack(), S.slack(), S.nwg % F.G, l >> 1);
        }
        GRID_BAR();
        { const Frame F = relaunder(F0);
            OpsDense O{1024, 1024, 1024, (const char*)(ws + WS_SB), (const char*)(ws + WS_WPB + (size_t)l * 1024 * 512 * 2), 0};
            pg8::DenseOrder S; S.init(nM, 4, F.G, bid);
            EpiMerge<1> E{(const bf16*)(ws + WS_SGB), (const bf16*)(ws + WS_HB), (bf16*)(ws + WS_MB)};
            RPT(13) { if (rep_) GRID_BAR(); PH(13) pg8::gemm_phase<0>(F.lds, F.wave, O, S, E); }
            bg_tail(F, l * 16 + 1, !S.slack(), S.slack(), S.nwg % F.G, l >> 1);
        }
        GRID_BAR();
        { const Frame F = relaunder(F0);
            OpsDense O{2048, 2048, 2048, (const char*)(ws + WS_MB), (const char*)(ws + WS_WOUT + (size_t)l * 1024 * 1024 * 2), 0};
            pg8::DenseOrder S; S.init(nM, 4, F.G, bid);
            EpiStore E{(bf16*)(ws + WS_MO), D};
            RPT(14) { if (rep_) GRID_BAR(); PH(14) pg8::gemm_phase<0>(F.lds, F.wave, O, S, E); }
            bg_tail(F, l * 16 + 2, !S.slack(), S.slack(), S.nwg % F.G, l >> 1);
        }
        GRID_BAR();
        RPT(15) { if (rep_) GRID_BAR(); PH(15) { const Frame F = relaunder(F0); const bool shadow = (NREP(15) == 2) && rep_ == 0;
            NpArgs P{}; P.xin_lat = (l == 0) ? (const void*)INP(I_X) : (const void*)OUTP(); P.xin_ctx = (l == 0) ? (const void*)INP(I_CTX) : (const void*)XC;
            P.xout_lat = last ? (void*)(ws + WS_XPARK) : (void*)OUTP(); P.xout_ctx = XC;
            P.ysrc = (const bf16*)(ws + WS_MO); P.gate = shadow ? (const float*)(ws + WS_ZERO) : (modb + (size_t)l * 9 * 6144); P.gate_off = 2048; P.gA = INP(I_NORMG) + (l * 4 + 1) * D;
            P.gB = INP(I_NORMG) + (l * 4 + 2) * D; P.modh = modb + (size_t)l * 9 * 6144; P.shift_off = 3072; P.scale_off = 4096; P.hout = HB; P.nrows = last ? TL : TT;
            if (l & 1) { P.wrouter = INP(I_WROUTER) + (size_t)(l >> 1) * D * 8; P.brouter = INP(I_BROUTER) + (l >> 1) * 8; P.cursor = (unsigned*)(CTLP() + CW_CURSOR + ((l >> 1) + (shadow ? 2 : 0)) * 8 * 64);
                P.tokrec = ws + WS_TOKREC; P.slottok = (int*)(ws + WS_SLOTTOK); if (f8) norm_pass<1, true, true, 1, true, true>(F, P); else norm_pass<1, true, true, 0, true, true>(F, P); }
            else { if (l == 0) norm_pass<1, true, false, 0, false, true>(F, P); else if (f8) norm_pass<1, true, false, 1, true, true>(F, P); else norm_pass<1, true, false, 0, true, true>(F, P); }
        } }
        GRID_BAR();
        if ((l & 1) == 0) {
            const int j = l >> 1;
            { const Frame F = relaunder(F0);
                pg8::DenseOrder S; S.init(nM, 22, F.G, bid);
                const char* W1p = (const char*)(ws + WS_FFN1 + (size_t)j * 2 * DFF * D * 2);
                if (f8) { OpsDense O{D, D, D, (const char*)HB, W1p, 0}; EpiSwiglu<true> E{ws + WS_HID, DFF, 0};
                    RPT(16) { if (rep_) GRID_BAR(); PH(16) pg8::gemm_phase<124>(F.lds, F.wave, O, S, E); } }
                else { OpsDense O{2 * D, 2 * D, 2 * D, (const char*)HB, W1p, 0}; EpiSwiglu<false> E{ws + WS_HID, DFF, 0};
                    RPT(16) { if (rep_) GRID_BAR(); PH(16) pg8::gemm_phase<0>(F.lds, F.wave, O, S, E); } }
                bg_tail(F, l * 16 + 3, !S.slack(), S.slack(), S.nwg % F.G, l >> 1);
            }
            GRID_BAR();
            { const Frame F = relaunder(F0);
                pg8::DenseOrder S; S.init(nM, 4, F.G, bid);
                const char* W2p = (const char*)(ws + WS_FFN2 + (size_t)j * D * DFF * 2);
                EpiStore E{(bf16*)(ws + WS_FY), D};
                if (f8) { OpsDense O{DFF, DFF, DFF, (const char*)(ws + WS_HID), W2p, 0};
                    RPT(17) { if (rep_) GRID_BAR(); PH(17) pg8::gemm_phase<124>(F.lds, F.wave, O, S, E); } }
                else { OpsDense O{2 * DFF, 2 * DFF, 2 * DFF, (const char*)(ws + WS_HID), W2p, 0};
                    RPT(17) { if (rep_) GRID_BAR(); PH(17) pg8::gemm_phase<0>(F.lds, F.wave, O, S, E); } }
                bg_tail(F, l * 16 + 4, !S.slack(), S.slack(), S.nwg % F.G, l >> 1);
            }
            GRID_BAR();
        } else {
            const int j = l >> 1;
            int ntiles;
            { const Frame F = relaunder(F0);
                const gu32* cursor = CTLP() + CW_CURSOR + j * 8 * 64;
                ntiles = moe_tables(F, cursor, tab_ebase, tab_tile);
                RPT(18) { if (rep_) GRID_BAR(); PH(18) moe_gather(F, tab_ebase, ntiles, (const int*)(ws + WS_SLOTTOK), HB, (bf16*)(ws + WS_ASORT), f8); }
                bg_work(F, j, j, 8, true);
            }
            GRID_BAR();
            const int npass = f8 ? 1 : 2, ptiles = f8 ? MOE_MAXTILES : MOE_PASS_TILES;
            for (int pass = 0; pass < npass; ++pass) {
                const int t0 = pass * ptiles, t1 = (t0 + ptiles) < ntiles ? (t0 + ptiles) : ntiles;
                { const Frame F = relaunder(F0);
                    pg8::MoeOrder S; S.init(t0, t1, 28, F.G, bid, tab_tile);
                    const char* W1p = (const char*)(ws + WS_EXP1 + (size_t)j * 8 * 2 * DFFE * D * 2);
                    if (f8) { OpsMoe O{D, D, D, (const char*)(ws + WS_ASORT), W1p, (size_t)2 * DFFE * D * 2, 0}; EpiSwiglu<true> E{ws + WS_HIDM, DFFE, t0};
                        RPT(19) { if (rep_) GRID_BAR(); PH(19) pg8::gemm_phase<124>(F.lds, F.wave, O, S, E); } }
                    else { OpsMoe O{2 * D, 2 * D, 2 * D, (const char*)(ws + WS_ASORT), W1p, (size_t)2 * DFFE * D * 2, 0}; EpiSwiglu<false> E{ws + WS_HIDM, DFFE, t0};
                        RPT(19) { if (rep_) GRID_BAR(); PH(19) pg8::gemm_phase<0>(F.lds, F.wave, O, S, E); } }
                    if (j == 0) bg_tail(F, l * 16 + 5 + 2 * pass, !S.slack(), S.slack(), S.nwg % F.G, 1);
                }
                GRID_BAR();
                { const Frame F = relaunder(F0);
                    pg8::MoeOrder S; S.init(t0, t1, 4, F.G, bid, tab_tile);
                    const char* W2p = (const char*)(ws + WS_EXP2 + (size_t)j * 8 * D * DFFE * 2);
                    EpiStore E{(bf16*)(ws + WS_YSLOT), D};
                    if (f8) { OpsMoe O{DFFE, DFFE, DFFE, (const char*)(ws + WS_HIDM) - (size_t)t0 * 256 * DFFE, W2p, (size_t)D * DFFE * 2, 0};
                        RPT(20) { if (rep_) GRID_BAR(); PH(20) pg8::gemm_phase<124>(F.lds, F.wave, O, S, E); } }
                    else { OpsMoe O{2 * DFFE, 2 * DFFE, 2 * DFFE, (const char*)(ws + WS_HIDM) - (size_t)t0 * 256 * DFFE * 2, W2p, (size_t)D * DFFE * 2, 0};
                        RPT(20) { if (rep_) GRID_BAR(); PH(20) pg8::gemm_phase<0>(F.lds, F.wave, O, S, E); } }
                    if (j == 0) bg_tail(F, l * 16 + 6 + 2 * pass, !S.slack(), S.slack(), S.nwg % F.G, 1);
                }
                GRID_BAR();
            }
        }
        RPT(21) { if (rep_) GRID_BAR(); PH(21) { const Frame F = relaunder(F0); const bool shadow = (NREP(21) == 2) && rep_ == 0;
            NpArgs P{}; P.xin_lat = last ? (const void*)(ws + WS_XPARK) : (const void*)OUTP(); P.xin_ctx = XC; P.xout_lat = OUTP(); P.xout_ctx = XC;
            P.gate = shadow ? (const float*)(ws + WS_ZERO) : (modb + (size_t)l * 9 * 6144); P.gate_off = 5120; P.gA = INP(I_NORMG) + (l * 4 + 3) * D; P.nrows = last ? TL : TT;
            if (!last) { P.gB = INP(I_NORMG) + ((l + 1) * 4 + 0) * D; P.modh = modb + (size_t)(l + 1) * 9 * 6144; P.shift_off = 0; P.scale_off = 1024; P.hout = HB; P.hout8 = ws + WS_H8; }
            if (l & 1) { P.ysrc = (const bf16*)(ws + WS_YSLOT); P.tokrec = ws + WS_TOKREC; P.ebase = tab_ebase;
                if (last) norm_pass<2, false, false, 0, true, false>(F, P); else norm_pass<2, true, false, 2, true, true>(F, P); }
            else { P.ysrc = (const bf16*)(ws + WS_FY); norm_pass<1, true, false, 2, true, true>(F, P); }
        } }
        if (!last) GRID_BAR();
    }
}

#undef ws
#undef modb
#undef HB
#undef XC
extern "C" void kernel_launch(void* const* d_in, const int* in_sizes, int n_in, void* d_out, int out_size, void* d_ws, size_t ws_size, hipStream_t stream) {
    static int grid = 0;
    if (grid == 0) {
        if (n_in != 30 || out_size != TL * D || ws_size < WS_END) { fprintf(stderr, "kernel_launch: unexpected shapes (n_in %d out %d ws %zu need %zu)\n", n_in, out_size, ws_size, (size_t)WS_END); grid = -1; return; }
        int dev = 0, cus = 0;
        if (hipGetDevice(&dev) != hipSuccess || hipDeviceGetAttribute(&cus, hipDeviceAttributeMultiprocessorCount, dev) != hipSuccess) { grid = -1; return; }
        if (hipFuncSetAttribute((const void*)hybrid_fwd, hipFuncAttributeMaxDynamicSharedMemorySize, LDS_BYTES) != hipSuccess) { fprintf(stderr, "kernel_launch: hipFuncSetAttribute failed\n"); grid = -1; return; }
        int per_cu = 0;
        if (hipOccupancyMaxActiveBlocksPerMultiprocessor(&per_cu, (const void*)hybrid_fwd, 512, LDS_BYTES) != hipSuccess || per_cu < 1) { fprintf(stderr, "kernel_launch: occupancy query says %d\n", per_cu); }
        (void)hipGetLastError();
        grid = cus;
    }
    if (grid < 0) return;
    if (hipMemsetAsync((char*)d_ws + WS_CTL, 0, CTL_ZERO_BYTES, stream) != hipSuccess) return;
    Args a{};
    for (int i = 0; i < 30; ++i) a.in[i] = (const float*)d_in[i];
    a.out = (float*)d_out; a.ws = (unsigned char*)d_ws;
    hipLaunchKernelGGL(hybrid_fwd, dim3(grid), dim3(512), LDS_BYTES, stream, a);
}
```

```cpp
#include <hip/hip_runtime.h>
#include <cstdio>
#include <cstdint>

#ifndef SKIPMASK
#define SKIPMASK 0ull
#endif
#define PH(id) if (!((SKIPMASK >> (id)) & 1ull))
#ifndef F8MASK
#define F8MASK 0xEu
#endif
#ifndef REPMASK
#define REPMASK 0ull
#endif
#define NREP(id) ((((REPMASK) >> (id)) & 1ull) ? 2 : 1)
#define RPT(id) for (int rep_ = 0; rep_ < NREP(id); ++rep_)
#define GAS __attribute__((address_space(1)))
#define LAS __attribute__((address_space(3)))
typedef unsigned short bf16;
typedef short bf16x8 __attribute__((ext_vector_type(8)));
typedef short s16x4 __attribute__((ext_vector_type(4)));
typedef float f32x2 __attribute__((ext_vector_type(2)));
typedef float f32x4 __attribute__((ext_vector_type(4)));
typedef float f32x16 __attribute__((ext_vector_type(16)));
typedef unsigned u32x2 __attribute__((ext_vector_type(2)));
typedef unsigned u32x4 __attribute__((ext_vector_type(4)));
typedef __bf16 bf16x2_t __attribute__((ext_vector_type(2)));
typedef GAS unsigned gu32;

constexpr int D = 1024, NB = 8, SEQ = 4096, CTXL = 256, DEPTH = 4;
constexpr int TL = NB * SEQ, TCX = NB * CTXL, TT = TL + TCX;
constexpr int DIN = 3328, DATT = 512, DKV = 128, DSSM = 512, DFF = 2816, DFFE = 3584, NEXP = 8;
constexpr int NG = 32, NST = 64, NH = 16, TCH = 32, NCHUNK = 136, SSM_ROWS = NB * NCHUNK, SSM_RPAD = 1280, AG_PITCH = 768;
constexpr float RMS_EPS = 1e-6f;
constexpr float LOG2E = 1.4426950408889634f;
constexpr float QSCALE = 0.125f * LOG2E;
constexpr int MOE_MAXTILES = 280, MOE_PASS_TILES = 140;
constexpr int NQKVU = 1280, NGATE = 2048;
constexpr size_t WIN_L = (size_t)NQKVU * D * 2 + (size_t)NGATE * D;

constexpr size_t al4k(size_t x) { return (x + 4095) & ~(size_t)4095; }
constexpr size_t WS_CTL = 0, CTL_ZERO_BYTES = 1u << 20;
constexpr size_t WS_ZERO = 524288;
constexpr size_t WS_MOD = CTL_ZERO_BYTES;
constexpr size_t WS_MODP = WS_MOD + al4k((size_t)4 * 9 * 6144 * 4);
constexpr size_t WS_ROPE = WS_MODP + al4k((size_t)16 * 4 * 9 * 6144 * 4);
constexpr size_t WS_POW = WS_ROPE + al4k((size_t)2 * 4096 * 32 * 4);
constexpr size_t WS_BBAR = WS_POW + al4k((size_t)4 * 2 * 32 * 64 * 33 * 8);
constexpr size_t WS_KFULL = WS_BBAR + al4k((size_t)4 * 2 * 32 * 64 * 16 * 8);
constexpr size_t WS_TOKREC = WS_KFULL + al4k((size_t)4 * 32 * 63 * 256 * 4);
constexpr size_t WS_SLOTTOK = WS_TOKREC + al4k((size_t)TT * 32);
constexpr size_t WS_XC = WS_SLOTTOK + al4k((size_t)8 * TT * 4);
constexpr size_t WS_WIN = WS_XC + al4k((size_t)TCX * D * 4);
constexpr size_t WS_WGLU = WS_WIN + (size_t)4 * DIN * D * 2;
constexpr size_t WS_WPA = WS_WGLU + (size_t)4 * 512 * 512 * 2;
constexpr size_t WS_WPB = WS_WPA + (size_t)4 * 1024 * 512 * 2;
constexpr size_t WS_WOUT = WS_WPB + (size_t)4 * 1024 * 512 * 2;
constexpr size_t WS_FFN1 = WS_WOUT + (size_t)4 * 1024 * 1024 * 2;
constexpr size_t WS_FFN2 = WS_FFN1 + (size_t)2 * 2 * DFF * D * 2;
constexpr size_t WS_EXP1 = WS_FFN2 + (size_t)2 * D * DFF * 2;
constexpr size_t WS_XPARK = WS_EXP1;
constexpr size_t WS_EXP2 = WS_EXP1 + (size_t)2 * 8 * 2 * DFFE * D * 2;
constexpr size_t WS_HB = WS_EXP2 + (size_t)2 * 8 * D * DFFE * 2;
constexpr size_t WS_R = WS_HB + (size_t)TT * D * 2;
constexpr size_t WS_QB = WS_R;
constexpr size_t WS_KB = WS_QB + (size_t)TT * 512 * 2;
constexpr size_t WS_VB = WS_KB + (size_t)TT * 128 * 2;
constexpr size_t WS_AG = WS_VB + (size_t)TT * 128 * 2;
constexpr size_t WS_SGA = WS_AG + (size_t)NG * SSM_RPAD * AG_PITCH * 2;
constexpr size_t WS_SGB = WS_SGA + (size_t)TT * D * 2;
constexpr size_t WS_AO = WS_SGB + (size_t)TT * D * 2;
constexpr size_t WS_GY = WS_AO + (size_t)TT * 512 * 2;
constexpr size_t WS_SB = WS_GY + (size_t)TT * 512 * 2;
constexpr size_t WS_H8 = WS_SB;
constexpr size_t WS_MB = WS_SB + (size_t)TT * 512 * 2;
constexpr size_t WS_EF = WS_MB + (size_t)TT * D * 2;
constexpr size_t WS_W1 = WS_EF + (size_t)NG * SSM_RPAD * 256 * 4;
constexpr size_t WS_BTY = WS_W1 + (size_t)NG * 256 * 512 * 2;
constexpr size_t WS_MIX_END = WS_BTY + (size_t)NG * 512 * 768 * 2;
constexpr size_t WS_MO = WS_QB;
static_assert(WS_MO + (size_t)TT * D * 2 <= WS_SGA, "MO overlay");
constexpr size_t WS_HID = WS_R;
constexpr size_t WS_FY = WS_HID + (size_t)TT * DFF * 2;
constexpr size_t WS_FFN_END = WS_FY + (size_t)TT * D * 2;
constexpr size_t WS_ASORT = WS_R;
constexpr size_t WS_YSLOT = WS_ASORT + (size_t)MOE_MAXTILES * 256 * D * 2;
constexpr size_t WS_HIDM = WS_YSLOT + (size_t)MOE_MAXTILES * 256 * D * 2;
constexpr size_t WS_MOE_END = WS_HIDM + (size_t)MOE_MAXTILES * 256 * DFFE;
constexpr size_t cmax(size_t a, size_t b) { return a > b ? a : b; }
constexpr size_t WS_END = cmax(cmax(WS_MIX_END, WS_FFN_END), WS_MOE_END);
static_assert(WS_END <= (size_t)1113000000, "workspace budget");

constexpr int CW_TMO = 0;
constexpr int CW_BAR = 4096;
constexpr int CW_QUEUE = 8192;
constexpr int CW_CURSOR = 12288;
constexpr int CW_BG = 16384;
constexpr int CW_DONE = 20480;

constexpr int RING_BYTES = 131072;
constexpr int TAB_OFF = RING_BYTES;
constexpr int MISC_OFF = RING_BYTES + 12288;
constexpr int LDS_BYTES = 147456;

#define RLX_AGENT __ATOMIC_RELAXED, __HIP_MEMORY_SCOPE_AGENT
#define LDS_WAIT() asm volatile("s_waitcnt lgkmcnt(0)" ::: "memory")
#define VM_WAIT() asm volatile("s_waitcnt vmcnt(0)" ::: "memory")

__device__ __forceinline__ unsigned pk_bf16(float lo, float hi) { f32x2 v = {lo, hi}; bf16x2_t b = __builtin_convertvector(v, bf16x2_t); return __builtin_bit_cast(unsigned, b); }
__device__ __forceinline__ float clamp448(float x) { return fminf(fmaxf(x, -448.0f), 448.0f); }
__device__ __forceinline__ unsigned pk_fp8x4(float a, float b, float c, float d) {
    int w = __builtin_amdgcn_cvt_pk_fp8_f32(clamp448(a), clamp448(b), 0, false); w = __builtin_amdgcn_cvt_pk_fp8_f32(clamp448(c), clamp448(d), w, true); return (unsigned)w; }
__device__ __forceinline__ unsigned pk_fp8x4_nc(float a, float b, float c, float d) { int w = __builtin_amdgcn_cvt_pk_fp8_f32(a, b, 0, false); w = __builtin_amdgcn_cvt_pk_fp8_f32(c, d, w, true); return (unsigned)w; }
__device__ __forceinline__ float bf_lo(unsigned u) { return __uint_as_float(u << 16); }
__device__ __forceinline__ float bf_hi(unsigned u) { return __uint_as_float(u & 0xffff0000u); }
__device__ __forceinline__ float fast_rcp(float x) { return __builtin_amdgcn_rcpf(x); }
__device__ __forceinline__ float fast_exp2(float x) { return __builtin_amdgcn_exp2f(x); }
__device__ __forceinline__ float sigmoid_f(float x) { return fast_rcp(1.0f + fast_exp2(-LOG2E * x)); }
__device__ __forceinline__ float silu_f(float x) { return x * sigmoid_f(x); }
__device__ __forceinline__ f32x2 sigmoid2(f32x2 x) { const f32x2 t = x * (-LOG2E); f32x2 e; e.x = fast_exp2(t.x); e.y = fast_exp2(t.y); const f32x2 d = e + 1.0f; f32x2 r; r.x = fast_rcp(d.x); r.y = fast_rcp(d.y); return r; }
__device__ __forceinline__ f32x4 gelu4(const f32x4& v);
__device__ __forceinline__ f32x4 sigmoid4(const f32x4& v) { const f32x2 a = sigmoid2((f32x2){v[0], v[1]}), b = sigmoid2((f32x2){v[2], v[3]}); return (f32x4){a.x, a.y, b.x, b.y}; }
__device__ __forceinline__ float gelu_tanh_f(float x) { const float u = 1.5957691216057308f * (x + 0.044715f * x * x * x); return x * fast_rcp(1.0f + fast_exp2(-LOG2E * u)); }
__device__ __forceinline__ float wave_sum(float v) {
#define DPPF(x, ctrl, rm) __builtin_bit_cast(float, __builtin_amdgcn_update_dpp(0, __builtin_bit_cast(int, (x)), (ctrl), (rm), 0xF, false))
    v += DPPF(v, 0xB1, 0xF); v += DPPF(v, 0x4E, 0xF); v += DPPF(v, 0x141, 0xF); v += DPPF(v, 0x140, 0xF);
    v += DPPF(v, 0x142, 0xA); v += DPPF(v, 0x143, 0xC);
#undef DPPF
    return __builtin_bit_cast(float, __builtin_amdgcn_readlane(__builtin_bit_cast(int, v), 63));
}

__device__ __forceinline__ f32x4 gelu4(const f32x4& v) { const f32x4 u = (v + (v * v * v) * 0.044715f) * 1.5957691216057308f; return v * sigmoid4(u); }
constexpr int HINT_PTAB_OFF = 131072 + 12288 + 256 + 8 * 31;
namespace pg8 {
constexpr int BM = 256, BK = 64, HALF = 128, HTB = HALF * BK * 2, STAGE_BYTES = 8 * HTB, NXCD = 8, WGM = 8;
__host__ __device__ __forceinline__ int lds_byte(int r, int c) { const int st = (r >> 4) * 2 + (c >> 5), rr = r & 15, cc = c & 31, ob = rr * 64 + cc * 2; return st * 1024 + (ob ^ (((ob >> 9) & 1) << 5)); }
__host__ __device__ __forceinline__ void stage_rc(int b, int& R, int& C) { const int st = b / 1024, sb = b % 1024, swz = sb ^ (((sb >> 9) & 1) << 5); R = (st >> 1) * 16 + swz / 64; C = (st & 1) * 32 + (swz % 64) / 2; }
__host__ __device__ __forceinline__ int perm32(int rho) { const int n = rho >> 4, i = rho & 15; return 8 * (i >> 2) + 4 * n + (i & 3); }
__device__ __forceinline__ int xcd_remap(int wgid, int nwg) { const int q = nwg / NXCD, r = nwg % NXCD, xcd = wgid % NXCD, off = wgid / NXCD; return (xcd < r ? xcd * (q + 1) : r * (q + 1) + (xcd - r) * q) + off; }

struct Unit { int pm, pn, g; };

struct DenseOrder {
    int nM, nN, nwg, G, c, skew;
    __device__ void init(int nM_, int nN_, int G_, int c_, int skew_ = 0) { nM = nM_; nN = nN_; nwg = nM * nN; G = G_; c = c_; skew = (skew_ && G_ == 256) ? 1 : 0; }
    __device__ __forceinline__ bool next(int i, Unit& u) const {
        long L = (long)i * G + c;
        if (skew) { if (c < 64) { if (i > 0) return false; L = c; } else { const int cc = c - 64; if (i == 0) L = 64 + cc; else if (i == 1) L = 256 + cc; else if (i == 2) L = 448 + cc; else return false; } }
        if (L >= nwg) return false;
        const int wgid = xcd_remap((int)L, nwg);
        const int nig = WGM * nN, gid = wgid / nig, fm = gid * WGM, gsz = (nM - fm) < WGM ? (nM - fm) : WGM;
        u.pm = fm + ((wgid % nig) % gsz); u.pn = (wgid % nig) / gsz; u.g = 0; return true;
    }
    __device__ __forceinline__ bool slack() const { const int r = nwg % G; return !skew && r != 0 && c >= r; }
};
struct GroupOrder {
    int nmt, npn, nwg, G, c;
    __device__ void init(int ngrp, int nmt_, int npn_, int G_, int c_) { nmt = nmt_; npn = npn_; nwg = ngrp * nmt * npn; G = G_; c = c_; }
    __device__ __forceinline__ bool next(int i, Unit& u) const {
        const long L = (long)i * G + c; if (L >= nwg) return false;
        const int w = xcd_remap((int)L, nwg);
        const int per = nmt * npn; u.g = w / per; const int r = w % per; u.pm = r / npn; u.pn = r % npn; return true;
    }
};
struct MoeOrder {
    int t0, npn, nwg, G, c; const LAS int* tile_e;
    __device__ void init(int t0_, int t1_, int npn_, int G_, int c_, const LAS int* te) { t0 = t0_; npn = npn_; nwg = (t1_ > t0_ ? (t1_ - t0_) : 0) * npn_; G = G_; c = c_; tile_e = te; }
    __device__ __forceinline__ bool next(int i, Unit& u) const {
        const long L = (long)i * G + c; if (L >= nwg) return false;
        const int w = xcd_remap((int)L, nwg);
        if (npn == 28) { const int hsz = (nwg / 28) * 14, ph = (w >= hsz) ? 1 : 0, r = w - ph * hsz; u.pm = t0 + r / 14; u.pn = ph * 14 + r % 14; }
        else { u.pm = t0 + w / npn; u.pn = w % npn; }
        u.g = tile_e[u.pm]; return true;
    }
    __device__ __forceinline__ bool slack() const { const int r = nwg % G; return r != 0 && c >= r; }
};

typedef int v8i32_t __attribute__((ext_vector_type(8)));
typedef int v4i32_t __attribute__((ext_vector_type(4)));
template <int WSC  , class Ops, class Epi, class Sched>
__device__ __forceinline__ void gemm_phase(LAS unsigned char* lds, int wave_id, const Ops& O, const Sched& S, const Epi& E, int hint_word = -1  ) {
    int wid_ = wave_id; asm volatile("" : "+s"(wid_));
    int lane_ = (int)__builtin_amdgcn_mbcnt_hi(~0u, __builtin_amdgcn_mbcnt_lo(~0u, 0u)) & 63; asm volatile("" : "+v"(lane_));
    const int wid = wid_, lane = lane_, tid = wid * 64 + lane, wr = wid >> 2, wc = wid & 3, fr = lane & 15, fq = lane >> 4;
    const int K = O.K, nt = K / 128, lda = O.lda, ldb = O.ldb;
    unsigned voffA[2], voffB[2];
#pragma unroll
    for (int i = 0; i < 2; ++i) { int R, C; stage_rc(tid * 16 + i * 8192, R, C); const int Rb = Epi::PERM ? ((R & ~31) + perm32(R & 31)) : R;
        voffA[i] = (unsigned)(R * lda + C * 2); voffB[i] = (unsigned)(Rb * ldb + C * 2); }
    const unsigned kstep = 128u;
    const unsigned hstepA = (unsigned)HALF * (unsigned)lda, hstepB = (unsigned)HALF * (unsigned)ldb;
    const __amdgpu_buffer_rsrc_t rsA = __builtin_amdgcn_make_buffer_rsrc((void*)O.A, 0, -1, 0x00020000), rsB = __builtin_amdgcn_make_buffer_rsrc((void*)O.B, 0, -1, 0x00020000);
    constexpr bool F8 = (WSC != 0);
#ifndef F8_ALIGN
#define F8_ALIGN 1
#endif
    constexpr bool ALIGN_EPI = F8 ? (F8_ALIGN != 0) : true;
    const int f8scale = WSC;
    const unsigned ldsw = (unsigned)wid * 1024u;
    const int aoff = lds_byte(wr * 64 + fr, fq * 8), boff = lds_byte(wc * 32 + fr, fq * 8);
#define PG8_SA(b, h) (((b) * 2 + (h)) * HTB)
#define PG8_SB(b, h) ((4 + (b) * 2 + (h)) * HTB)
#define PG8_STAGE(bufoff, soff, voff) do { _Pragma("unroll") for (int _i = 0; _i < 2; ++_i) \
        __builtin_amdgcn_raw_ptr_buffer_load_lds((&(voff)[0] == &voffA[0]) ? rsA : rsB, (LAS void*)(lds + (bufoff) + ldsw + _i * 8192), 16, (int)(voff)[_i], (int)(soff), 0, 0); } while (0)
#define PG8_CAT(p) __builtin_shufflevector(*(const LAS v4i32_t*)(p), *(const LAS v4i32_t*)((p) + 1024), 0, 1, 2, 3, 4, 5, 6, 7)
#define PG8_LDA(dst, b, h) do { _Pragma("unroll") for (int m = 0; m < 4; ++m) { if constexpr (F8) dst##8[m] = PG8_CAT(lds + PG8_SA(b, h) + aoff + m * 2048); else { _Pragma("unroll") for (int k = 0; k < 2; ++k) dst[m][k] = *(const LAS bf16x8*)(lds + PG8_SA(b, h) + aoff + m * 2048 + k * 1024); } } } while (0)
#define PG8_LDB(dst, b, h) do { _Pragma("unroll") for (int n = 0; n < 2; ++n) { if constexpr (F8) dst##8[n] = PG8_CAT(lds + PG8_SB(b, h) + boff + n * 2048); else { _Pragma("unroll") for (int k = 0; k < 2; ++k) dst[n][k] = *(const LAS bf16x8*)(lds + PG8_SB(b, h) + boff + n * 2048 + k * 1024); } } } while (0)
#define PG8_MMA(ai, bj, At, Bt) do { __builtin_amdgcn_s_setprio(1); \
        if constexpr (F8) { asm volatile("s_nop 1\n\t" \
            "v_mfma_scale_f32_16x16x128_f8f6f4 %0, %8, %10, %0, %14, %14 op_sel_hi:[0,0,0]\n\t" "v_mfma_scale_f32_16x16x128_f8f6f4 %1, %9, %10, %1, %14, %14 op_sel_hi:[0,0,0]\n\t" \
            "v_mfma_scale_f32_16x16x128_f8f6f4 %2, %8, %11, %2, %14, %14 op_sel_hi:[0,0,0]\n\t" "v_mfma_scale_f32_16x16x128_f8f6f4 %3, %9, %11, %3, %14, %14 op_sel_hi:[0,0,0]\n\t" \
            "v_mfma_scale_f32_16x16x128_f8f6f4 %4, %8, %12, %4, %14, %14 op_sel_hi:[0,0,0]\n\t" "v_mfma_scale_f32_16x16x128_f8f6f4 %5, %9, %12, %5, %14, %14 op_sel_hi:[0,0,0]\n\t" \
            "v_mfma_scale_f32_16x16x128_f8f6f4 %6, %8, %13, %6, %14, %14 op_sel_hi:[0,0,0]\n\t" "v_mfma_scale_f32_16x16x128_f8f6f4 %7, %9, %13, %7, %14, %14 op_sel_hi:[0,0,0]" \
            : "+v"(acc[ai][bj][0][0]), "+v"(acc[ai][bj][0][1]), "+v"(acc[ai][bj][1][0]), "+v"(acc[ai][bj][1][1]), "+v"(acc[ai][bj][2][0]), "+v"(acc[ai][bj][2][1]), "+v"(acc[ai][bj][3][0]), "+v"(acc[ai][bj][3][1]) \
            : "v"(Bt##8[0]), "v"(Bt##8[1]), "v"(At##8[0]), "v"(At##8[1]), "v"(At##8[2]), "v"(At##8[3]), "v"(f8scale)); } \
        else { _Pragma("unroll") for (int m = 0; m < 4; ++m) _Pragma("unroll") for (int n = 0; n < 2; ++n) _Pragma("unroll") for (int k = 0; k < 2; ++k) \
            acc[ai][bj][m][n] = __builtin_amdgcn_mfma_f32_16x16x32_bf16(Bt[n][k], At[m][k], acc[ai][bj][m][n], 0, 0, 0); } \
        __builtin_amdgcn_s_setprio(0); } while (0)
#define PG8_WAIT_V(n) asm volatile("s_waitcnt vmcnt(" #n ")" ::: "memory")
#define PG8_WAIT_L(n) asm volatile("s_waitcnt lgkmcnt(" #n ")" ::: "memory")
#define PG8_BAR __builtin_amdgcn_s_barrier()
#define PG8_SCHED __builtin_amdgcn_sched_barrier(0)
    Unit cur, nxt; int ui = 0;
    if (!S.next(0, cur)) return;
    f32x4 acc[2][2][4][2];
#pragma unroll
    for (int a = 0; a < 2; ++a)
#pragma unroll
        for (int b = 0; b < 2; ++b)
#pragma unroll
            for (int m = 0; m < 4; ++m)
#pragma unroll
                for (int n = 0; n < 2; ++n) acc[a][b][m][n] = (f32x4){0.f, 0.f, 0.f, 0.f};
    bf16x8 At[4][2], B0[2][2], B1[2][2]; v8i32_t At8[4], B08[2], B18[2];
    unsigned cA = __builtin_amdgcn_readfirstlane(O.a_off(cur)), cB = __builtin_amdgcn_readfirstlane(O.b_off(cur));
    PG8_STAGE(PG8_SB(0, 0), cB, voffB); PG8_STAGE(PG8_SB(0, 1), cB + hstepB, voffB); PG8_STAGE(PG8_SA(0, 0), cA, voffA); PG8_STAGE(PG8_SA(0, 1), cA + hstepA, voffA);
    if (wr == 1) PG8_BAR;
    PG8_WAIT_V(2); PG8_BAR;
    PG8_STAGE(PG8_SB(1, 0), cB + kstep, voffB); PG8_STAGE(PG8_SA(1, 0), cA + kstep, voffA); PG8_STAGE(PG8_SB(1, 1), cB + hstepB + kstep, voffB);
    PG8_WAIT_V(6); PG8_BAR;
    for (;;) {
        const bool has_next = S.next(ui + 1, nxt);
        const unsigned nA = has_next ? __builtin_amdgcn_readfirstlane(O.a_off(nxt)) : cA, nB = has_next ? __builtin_amdgcn_readfirstlane(O.b_off(nxt)) : cB;
        for (int t = 0; t < nt; t += 2) {
            const bool last = (t == nt - 2);
            const unsigned a1 = cA + (unsigned)(t + 1) * kstep;
            const unsigned a2 = last ? nA : cA + (unsigned)(t + 2) * kstep, b2 = last ? nB : cB + (unsigned)(t + 2) * kstep;
            const unsigned a3 = a2 + kstep, b3 = b2 + kstep;
            PG8_LDB(B0, 0, 0); PG8_LDB(B1, 0, 1); PG8_SCHED; PG8_LDA(At, 0, 0); PG8_STAGE(PG8_SA(1, 1), a1 + hstepA, voffA);
            PG8_WAIT_V(8); PG8_WAIT_L(0); PG8_BAR; PG8_MMA(0, 0, At, B0); PG8_MMA(0, 1, At, B1); PG8_BAR; PG8_SCHED;
            PG8_LDA(At, 0, 1); PG8_STAGE(PG8_SB(0, 0), b2, voffB); PG8_STAGE(PG8_SB(0, 1), b2 + hstepB, voffB); PG8_STAGE(PG8_SA(0, 0), a2, voffA);
            PG8_WAIT_V(8); PG8_WAIT_L(0); PG8_BAR; PG8_MMA(1, 0, At, B0); PG8_MMA(1, 1, At, B1); PG8_BAR; PG8_SCHED;
            PG8_LDB(B0, 1, 0); PG8_LDB(B1, 1, 1); PG8_SCHED; PG8_LDA(At, 1, 0); PG8_STAGE(PG8_SA(0, 1), a2 + hstepA, voffA);
            PG8_WAIT_V(8); PG8_WAIT_L(0); PG8_BAR; PG8_MMA(0, 0, At, B0); PG8_MMA(0, 1, At, B1); PG8_BAR; PG8_SCHED;
            PG8_LDA(At, 1, 1); PG8_STAGE(PG8_SB(1, 0), b3, voffB); PG8_STAGE(PG8_SB(1, 1), b3 + hstepB, voffB); PG8_STAGE(PG8_SA(1, 0), a3, voffA);
            PG8_WAIT_V(8); PG8_WAIT_L(0); PG8_BAR; PG8_MMA(1, 0, At, B0); PG8_MMA(1, 1, At, B1); PG8_BAR; PG8_SCHED;
        }
        if constexpr (ALIGN_EPI) { if (wr == 0) PG8_BAR; }
        if constexpr (F8) asm volatile("s_nop 15\n\ts_nop 7" ::: "memory");
        if (!has_next && hint_word >= 0 && tid == 0) { unsigned po = HINT_PTAB_OFF; asm volatile("" : "+v"(po)); volatile LAS unsigned* pp = (volatile LAS unsigned*)(lds + po);
            const unsigned long long wsb = ((unsigned long long)pp[1] << 32) | pp[0]; __hip_atomic_fetch_add((GAS unsigned*)wsb + hint_word, 1u, __ATOMIC_RELAXED, __HIP_MEMORY_SCOPE_AGENT); }
        E(acc, cur, wr, wc, fr, fq);
        if (!has_next) break;
#pragma unroll
        for (int a = 0; a < 2; ++a)
#pragma unroll
            for (int b = 0; b < 2; ++b)
#pragma unroll
                for (int m = 0; m < 4; ++m)
#pragma unroll
                    for (int n = 0; n < 2; ++n) acc[a][b][m][n] = (f32x4){0.f, 0.f, 0.f, 0.f};
        cur = nxt; cA = nA; cB = nB; ++ui;
        if constexpr (ALIGN_EPI) { if (wr == 1) PG8_BAR; }
    }
    PG8_WAIT_V(0);
    if constexpr (!ALIGN_EPI) { if (wr == 0) PG8_BAR; }
    PG8_BAR;
#undef PG8_SA
#undef PG8_SB
#undef PG8_STAGE
#undef PG8_CAT
#undef PG8_LDA
#undef PG8_LDB
#undef PG8_MMA
#undef PG8_WAIT_V
#undef PG8_WAIT_L
#undef PG8_BAR
#undef PG8_SCHED
}
}
using pg8::Unit;

#define XB_TMO      128
#define XB_XCNT(j)  (256  + 64 * (j))
#define XB_XSUB(j)  (1280 + 64 * (j))
#define XB_XGEN(j)  (2304 + 64 * (j))
#define XB_TOP      3328
#define XB_TOPGEN   3392
#define XCD_BAR_WORDS 3456
#define XB_SPIN_CAP (1u << 18)
__device__ __forceinline__ unsigned xb_ld(unsigned* p)              { return __hip_atomic_load(p, __ATOMIC_RELAXED, __HIP_MEMORY_SCOPE_AGENT); }
__device__ __forceinline__ unsigned xb_add(unsigned* p, unsigned v) { return __hip_atomic_fetch_add(p, v, __ATOMIC_RELAXED, __HIP_MEMORY_SCOPE_AGENT); }
__device__ __forceinline__ unsigned xb_xcc_id() { return (unsigned)__builtin_amdgcn_s_getreg((3 << 11) | 20) & 0xFu; }
#define XB_SPIN(cond, bar) do { unsigned _sp = 0; while (cond) { __builtin_amdgcn_s_sleep(1); \
    if ((++_sp & 255u) == 0u) { if (xb_ld(&(bar)[XB_TMO])) break; if (_sp > XB_SPIN_CAP) { atomicAdd(&(bar)[XB_TMO], 1u); break; } } } } while (0)
struct XcdBarrier { unsigned* bar; unsigned x; volatile LAS unsigned* st; };
__device__ __forceinline__ XcdBarrier xcd_barrier_post(unsigned* bar, volatile LAS unsigned* st) {
    XcdBarrier b; b.bar = bar; b.x = xb_xcc_id(); b.st = st;
    if (threadIdx.x == 0) (void)xb_add(&bar[XB_XCNT(b.x)], 1u);
    return b;
}
__device__ __forceinline__ void xcd_barrier_complete(unsigned* bar, unsigned x, unsigned& nloc, unsigned& nx) {
    const unsigned G = gridDim.x * gridDim.y * gridDim.z;
    unsigned sum, cnt, mine, sp = 0u;
    for (;;) {
        sum = 0u; cnt = 0u; mine = 0u;
#pragma unroll
        for (unsigned j = 0; j < 16; ++j) { const unsigned c = xb_ld(&bar[XB_XCNT(j)]); sum += c; cnt += (c > 0u) ? 1u : 0u; mine = (j == x) ? c : mine; }
        if (sum == G) break;
        __builtin_amdgcn_s_sleep(1);
        if ((++sp & 255u) == 0u) { if (xb_ld(&bar[XB_TMO])) break; if (sp > XB_SPIN_CAP) { atomicAdd(&bar[XB_TMO], 1u); break; } }
    }
    nloc = mine > 0u ? mine : 1u; nx = cnt > 0u ? cnt : 1u;
}
__device__ __forceinline__ void xcd_barrier(const XcdBarrier& b, bool leader  ) {
    asm volatile("s_waitcnt vmcnt(0)" ::: "memory");
    __syncthreads();
    if (leader) {
        unsigned* bar = b.bar;
        __builtin_amdgcn_s_waitcnt(0);
        unsigned nloc = b.st[0], nx = b.st[1];
        if (nloc == 0u) { xcd_barrier_complete(bar, b.x, nloc, nx); b.st[0] = nloc; b.st[1] = nx; }
        const unsigned old = xb_add(&bar[XB_XSUB(b.x)], 1u);
        const unsigned gen = old / nloc;
        if (old + 1u == (gen + 1u) * nloc) {
            __builtin_amdgcn_fence(__ATOMIC_RELEASE, "agent");
            asm volatile("s_waitcnt vmcnt(0)" ::: "memory");
            const unsigned og = xb_add(&bar[XB_TOP], 1u);
            const unsigned tg = og / nx;
            if (og + 1u == (tg + 1u) * nx) xb_add(&bar[XB_TOPGEN], 1u);
            else XB_SPIN(xb_ld(&bar[XB_TOPGEN]) == tg, bar);
            __builtin_amdgcn_fence(__ATOMIC_ACQUIRE, "agent");
            xb_add(&bar[XB_XGEN(b.x)], 1u);
            asm volatile("s_waitcnt vmcnt(0)" ::: "memory");
        } else {
            XB_SPIN(xb_ld(&bar[XB_XGEN(b.x)]) == gen, bar);
            __builtin_amdgcn_fence(__ATOMIC_ACQUIRE, "agent");
            asm volatile("s_waitcnt vmcnt(0)" ::: "memory");
        }
    }
    __syncthreads();
}

struct Args { const float* in[30]; float* out; unsigned char* ws; };
enum { I_X = 0, I_C, I_CTX, I_CCTX, I_WMOD, I_BMOD, I_NORMG, I_WIN, I_SINK, I_ARE, I_AIM, I_LOGDT, I_BRE, I_BIM, I_CRE, I_CIM, I_SSMD, I_WGLU, I_BGLU,
       I_WPA, I_WPB, I_WOUT, I_FGATE, I_FUP, I_FDOWN, I_WROUTER, I_BROUTER, I_EGATE, I_EUP, I_EDOWN };

struct Frame {
    LAS unsigned char* lds;
    int tid, lane, wave, G, vcu;
};
__device__ __forceinline__ Frame relaunder(const Frame& F0) { Frame F = F0; asm volatile("" : "+s"(F.wave)); asm volatile("" : "+s"(F.vcu));
    F.lane = (int)__builtin_amdgcn_mbcnt_hi(~0u, __builtin_amdgcn_mbcnt_lo(~0u, 0u)) & 63; asm volatile("" : "+v"(F.lane)); F.tid = F.wave * 64 + F.lane; return F; }
constexpr int PTAB_OFF = RING_BYTES + 12288 + 256;
static_assert(HINT_PTAB_OFF == PTAB_OFF + 8 * 31 && WS_CTL == 0, "hint pointer");
__device__ __forceinline__ unsigned long long ptab_get(const Frame& F, int i) {
    unsigned off = PTAB_OFF + 8 * i; asm volatile("" : "+v"(off));
    volatile LAS unsigned* p = (volatile LAS unsigned*)(F.lds + off);
    const unsigned lo = __builtin_amdgcn_readfirstlane(p[0]), hi = __builtin_amdgcn_readfirstlane(p[1]);
    return ((unsigned long long)hi << 32) | lo;
}
#define INP(i) ((const float*)(const GAS float*)ptab_get(F, (i)))
#define OUTP() ((float*)(GAS float*)ptab_get(F, 30))
#define WSP() ((unsigned char*)(GAS unsigned char*)ptab_get(F, 31))
#define CTLP() ((gu32*)(WSP() + WS_CTL))

template <int MAP  >
__device__ __forceinline__ int row_map(int n) {
    if (MAP == 1) { if (n < 640) { const int d = n & 63; return (n & ~63) + (d < 32 ? 2 * d : 2 * (d - 32) + 1); } return n; }
    if (MAP == 2) return (n >> 7) * 256 + (n & 127);
    if (MAP == 3) return (n >> 7) * 256 + 128 + (n & 127);
    if (MAP == 4) return n - NQKVU;
    return n;
}
template <int MAP>
__device__ __forceinline__ void transpose_item8(const float* W, int K, int N, unsigned char* WT, float wmul, LAS float* scr, int item, int lane) {
    const int nblk = N / 32, kb = item / nblk, nb = item % nblk, k0 = 64 * kb, n0 = 32 * nb;
    { const int kr = lane >> 3, nc = (lane & 7) * 4; f32x4 v[8];
#pragma unroll
      for (int i = 0; i < 8; ++i) v[i] = *(const f32x4*)(W + (size_t)(k0 + 8 * i + kr) * N + n0 + nc);
#pragma unroll
      for (int i = 0; i < 8; ++i) { LAS float* d = scr + (8 * i + kr) * 33 + nc; d[0] = v[i].x * wmul; d[1] = v[i].y * wmul; d[2] = v[i].z * wmul; d[3] = v[i].w * wmul; } }
    LDS_WAIT(); asm volatile("" ::: "memory");
    const int c = lane & 7;
#pragma unroll
    for (int j = 0; j < 4; ++j) { const int n = (lane >> 3) + 8 * j; const LAS float* s = scr + (8 * c) * 33 + n;
        u32x2 o; o.x = pk_fp8x4(s[0 * 33], s[1 * 33], s[2 * 33], s[3 * 33]); o.y = pk_fp8x4(s[4 * 33], s[5 * 33], s[6 * 33], s[7 * 33]);
        *(u32x2*)(WT + (size_t)row_map<MAP>(n0 + n) * K + k0 + 8 * c) = o; }
    LDS_WAIT(); asm volatile("" ::: "memory");
}
template <int MAP>
__device__ __forceinline__ void transpose_item(const float* W, int K, int N, bf16* WT, LAS float* scr, int item, int lane) {
    const int nblk = N / 32, kb = item / nblk, nb = item % nblk, k0 = 64 * kb, n0 = 32 * nb;
    { const int kr = lane >> 3, nc = (lane & 7) * 4; f32x4 v[8];
#pragma unroll
      for (int i = 0; i < 8; ++i) v[i] = *(const f32x4*)(W + (size_t)(k0 + 8 * i + kr) * N + n0 + nc);
#pragma unroll
      for (int i = 0; i < 8; ++i) { LAS float* d = scr + (8 * i + kr) * 33 + nc; d[0] = v[i].x; d[1] = v[i].y; d[2] = v[i].z; d[3] = v[i].w; } }
    LDS_WAIT(); asm volatile("" ::: "memory");
    const int c = lane & 7;
#pragma unroll
    for (int j = 0; j < 4; ++j) { const int n = (lane >> 3) + 8 * j; const LAS float* s = scr + (8 * c) * 33 + n;
        u32x4 o; o.x = pk_bf16(s[0 * 33], s[1 * 33]); o.y = pk_bf16(s[2 * 33], s[3 * 33]); o.z = pk_bf16(s[4 * 33], s[5 * 33]); o.w = pk_bf16(s[6 * 33], s[7 * 33]);
        *(u32x4*)(WT + (size_t)row_map<MAP>(n0 + n) * K + k0 + 8 * c) = o; }
    LDS_WAIT(); asm volatile("" ::: "memory");
}

constexpr int MOD_ITEMS = 4 * 24 * 16;
__device__ __forceinline__ void mod_item(const Frame& F, int item);
__device__ __forceinline__ void p0_weights(const Frame& F) {
    LAS float* scr = (LAS float*)(F.lds + F.wave * 8448);
    const int gw = F.vcu * 8 + F.wave, NGW = F.G * 8;
    constexpr int I_IN = 16 * 104, I_GLU = 8 * 16, I_PA = 8 * 32, I_OUT = 16 * 32, PER_L = I_IN + I_GLU + 2 * I_PA + I_OUT;
    constexpr int I_F = 16 * 88, PER_F = 3 * I_F;
    constexpr int N1 = 4 * PER_L, N2 = N1 + 2 * PER_F;
    bf16* ws_win = (bf16*)(WSP() + WS_WIN); bf16* ws_glu = (bf16*)(WSP() + WS_WGLU); bf16* ws_pa = (bf16*)(WSP() + WS_WPA); bf16* ws_pb = (bf16*)(WSP() + WS_WPB);
    bf16* ws_out = (bf16*)(WSP() + WS_WOUT); unsigned char* ws_f1 = WSP() + WS_FFN1; unsigned char* ws_f2 = WSP() + WS_FFN2;
    for (int it0 = gw; it0 < N2 + MOD_ITEMS; it0 += NGW) {
        if (it0 < MOD_ITEMS) { mod_item(F, it0); continue; }
        const int it = it0 - MOD_ITEMS;
        if (it < N1) {
            const int l = it / PER_L; int r = it % PER_L;
            if (r < I_IN) { unsigned char* wl = (unsigned char*)ws_win + (size_t)l * WIN_L;
                if ((r % 104) < 40) transpose_item<1>(INP(I_WIN) + (size_t)l * D * DIN, D, DIN, (bf16*)wl, scr, r, F.lane);
                else transpose_item8<4>(INP(I_WIN) + (size_t)l * D * DIN, D, DIN, wl + (size_t)NQKVU * D * 2, 64.0f, scr, r, F.lane);
                continue; } r -= I_IN;
            if (r < I_GLU) { transpose_item<0>(INP(I_WGLU) + (size_t)l * 512 * 512, 512, 512, ws_glu + (size_t)l * 512 * 512, scr, r, F.lane); continue; } r -= I_GLU;
            if (r < I_PA) { transpose_item<0>(INP(I_WPA) + (size_t)l * 512 * 1024, 512, 1024, ws_pa + (size_t)l * 1024 * 512, scr, r, F.lane); continue; } r -= I_PA;
            if (r < I_PA) { transpose_item<0>(INP(I_WPB) + (size_t)l * 512 * 1024, 512, 1024, ws_pb + (size_t)l * 1024 * 512, scr, r, F.lane); continue; } r -= I_PA;
            transpose_item<0>(INP(I_WOUT) + (size_t)l * 1024 * 1024, 1024, 1024, ws_out + (size_t)l * 1024 * 1024, scr, r, F.lane);
        } else if (it < N2) {
            const int q = it - N1, j = q / PER_F; int r = q % PER_F; const bool f8 = (F8MASK >> (2 * j)) & 1u;
            unsigned char* d1 = ws_f1 + (size_t)j * 2 * DFF * D * 2; unsigned char* d2 = ws_f2 + (size_t)j * D * DFF * 2;
            if (r < I_F) { if (f8) transpose_item8<2>(INP(I_FGATE) + (size_t)j * D * DFF, D, DFF, d1, 64.0f, scr, r, F.lane); else transpose_item<2>(INP(I_FGATE) + (size_t)j * D * DFF, D, DFF, (bf16*)d1, scr, r, F.lane); continue; } r -= I_F;
            if (r < I_F) { if (f8) transpose_item8<3>(INP(I_FUP) + (size_t)j * D * DFF, D, DFF, d1, 64.0f, scr, r, F.lane); else transpose_item<3>(INP(I_FUP) + (size_t)j * D * DFF, D, DFF, (bf16*)d1, scr, r, F.lane); continue; } r -= I_F;
            if (f8) transpose_item8<0>(INP(I_FDOWN) + (size_t)j * DFF * D, DFF, D, d2, 64.0f, scr, r, F.lane); else transpose_item<0>(INP(I_FDOWN) + (size_t)j * DFF * D, DFF, D, (bf16*)d2, scr, r, F.lane);
        }
    }
}

#ifndef BGN
#define BGN(x) (x)
#endif
constexpr int BGN_GLU = BGN(3), BGN_PB = BGN(4), BGN_OUT = BGN(5), BGN_F1B = BGN(4), BGN_F1F = BGN(2), BGN_F2B = BGN(9), BGN_F2F = BGN(5), BGN_M1 = BGN(2), BGN_M2 = BGN(6);
#ifndef BG_WAVES
#define BG_WAVES 8
#endif
constexpr int BG_I_E = 16 * 112, BG_PER_E = 3 * BG_I_E, BG_ITEMS = 8 * BG_PER_E;
__device__ __forceinline__ void moe_weight_item(const Frame& F, LAS float* scr, int j, int q) {
    const int je = j * 8 + q / BG_PER_E; int r = q % BG_PER_E; const bool f8 = (F8MASK >> (2 * j + 1)) & 1u;
    unsigned char* d1 = WSP() + WS_EXP1 + (size_t)je * 2 * DFFE * D * 2; unsigned char* d2 = WSP() + WS_EXP2 + (size_t)je * D * DFFE * 2;
    if (r < BG_I_E) { if (f8) transpose_item8<2>(INP(I_EGATE) + (size_t)je * D * DFFE, D, DFFE, d1, 64.0f, scr, r, F.lane); else transpose_item<2>(INP(I_EGATE) + (size_t)je * D * DFFE, D, DFFE, (bf16*)d1, scr, r, F.lane); return; } r -= BG_I_E;
    if (r < BG_I_E) { if (f8) transpose_item8<3>(INP(I_EUP) + (size_t)je * D * DFFE, D, DFFE, d1, 64.0f, scr, r, F.lane); else transpose_item<3>(INP(I_EUP) + (size_t)je * D * DFFE, D, DFFE, (bf16*)d1, scr, r, F.lane); return; } r -= BG_I_E;
    if (f8) transpose_item8<0>(INP(I_EDOWN) + (size_t)je * DFFE * D, DFFE, D, d2, 64.0f, scr, r, F.lane); else transpose_item<0>(INP(I_EDOWN) + (size_t)je * DFFE * D, DFFE, D, (bf16*)d2, scr, r, F.lane);
}
__device__ __forceinline__ void bg_work(const Frame& F, int j, int jlast, int nmax, bool drain = false) {
    volatile LAS unsigned* MISC = (volatile LAS unsigned*)(F.lds + MISC_OFF);
    LAS float* scr = (LAS float*)(F.lds + F.wave * 8448);
    while (j <= jlast) {
        __syncthreads();
        if (F.tid == 0) MISC[17] = __hip_atomic_fetch_add(CTLP() + CW_BG + 64 * j, (unsigned)(8 * nmax), RLX_AGENT);
        __syncthreads();
        const unsigned t0 = (unsigned)__builtin_amdgcn_readfirstlane((int)MISC[17]);
        if (t0 >= (unsigned)BG_ITEMS) { ++j; continue; }
        for (int k = 0; k < nmax; ++k) { const unsigned t = t0 + 8u * (unsigned)k + (unsigned)F.wave; if (t < (unsigned)BG_ITEMS) moe_weight_item(F, scr, j, (int)t); }
        if (!drain) break;
    }
}

__device__ __forceinline__ void bg_tail(const Frame& F, int slot, bool count, bool fill, int nbusy, int j) {
    volatile LAS unsigned* MISC = (volatile LAS unsigned*)(F.lds + MISC_OFF);
    gu32* done = CTLP() + CW_DONE + 64 * slot;
    if (count && F.tid == 0) __hip_atomic_fetch_add(done, 1u, RLX_AGENT);
    if (!fill) return;
    LAS float* scr = (LAS float*)(F.lds + F.wave * 8448);
    while (j <= 1) {
        __syncthreads();
        if (F.tid == 0) { unsigned t = 0xffffffffu;
            if (MISC[18] == 0u && __hip_atomic_load(done, RLX_AGENT) < (unsigned)nbusy) t = __hip_atomic_fetch_add(CTLP() + CW_BG + 64 * j, (unsigned)BG_WAVES, RLX_AGENT);
            MISC[17] = t; }
        __syncthreads();
        const unsigned t0 = (unsigned)__builtin_amdgcn_readfirstlane((int)MISC[17]);
        if (t0 == 0xffffffffu) break;
        if (t0 >= (unsigned)BG_ITEMS) { if (j == 1 && F.tid == 0) MISC[18] = 1u; ++j; continue; }
        const unsigned t = t0 + (unsigned)F.wave; if (F.wave < BG_WAVES && t < (unsigned)BG_ITEMS) moe_weight_item(F, scr, j, (int)t);
    }
}

__device__ __forceinline__ void p0_tables(const Frame& F) {
    const int gt = F.vcu * 512 + F.tid, NT = F.G * 512;
    float* ropec = (float*)(WSP() + WS_ROPE); float* ropes = ropec + 4096 * 32;
    for (int i = gt; i < 4096 * 32; i += NT) {
        const int pos = i >> 5, j = i & 31; const float rowf = (float)(pos >> 6), colf = (float)(pos & 63);
        const float invf = powf(10000.0f, -(float)(j & 15) / 16.0f);
        const float ang = (j < 16 ? rowf : colf) * invf;
        ropec[i] = cosf(ang); ropes[i] = sinf(ang);
    }
    f32x2* powt = (f32x2*)(WSP() + WS_POW);
    for (int i = gt; i < 4 * 2 * 32 * 64 * 33; i += NT) {
        const int k = i % 33, q = i / 33;
        const int ldg = q >> 6;
        const float are = INP(I_ARE)[q], aim = INP(I_AIM)[q], dt = expf(INP(I_LOGDT)[ldg]);
        const float mag = expf((float)k * are * dt), ang = (float)k * aim * dt;
        powt[i] = (f32x2){mag * cosf(ang), mag * sinf(ang)};
    }
    f32x2* bbar = (f32x2*)(WSP() + WS_BBAR);
    for (int i = gt; i < 4 * 2 * 32 * 64 * 16; i += NT) {
        const int q = i >> 4, ldg = q >> 6;
        const float are = INP(I_ARE)[q], aim = INP(I_AIM)[q], dt = expf(INP(I_LOGDT)[ldg]);
        const float mag = expf(are * dt), ang = aim * dt;
        const float lr = mag * cosf(ang) - 1.0f, li = mag * sinf(ang);
        const float den = 1.0f / (are * are + aim * aim);
        const float cr = (lr * are + li * aim) * den, ci = (li * are - lr * aim) * den;
        const float br = INP(I_BRE)[i], bi = INP(I_BIM)[i];
        bbar[i] = (f32x2){cr * br - ci * bi, cr * bi + ci * br};
    }
}

constexpr int SC_OFF = 69632;
__device__ __forceinline__ void mod_sc_init(const Frame& F) {
    LAS float* sc = (LAS float*)(F.lds + SC_OFF);
    for (int i = F.tid; i < 9 * 1024; i += 512) { const float v = i < 8192 ? INP(I_C)[i] : INP(I_CCTX)[i - 8192]; sc[i] = v / (1.0f + expf(-v)); }
    __syncthreads();
}
__device__ __forceinline__ void mod_item(const Frame& F, int item) {
    const int kc = item & 15, cc = (item >> 4) % 24, l = item / 384;
    const LAS float* sc = (const LAS float*)(F.lds + SC_OFF) + kc * 64;
    const float* W = INP(I_WMOD) + (size_t)l * D * 6144 + (size_t)(kc * 64) * 6144 + cc * 256 + F.lane * 4;
    f32x4 acc[9];
#pragma unroll
    for (int r = 0; r < 9; ++r) acc[r] = (f32x4){0.f, 0.f, 0.f, 0.f};
    for (int k0 = 0; k0 < 64; k0 += 16) {
        f32x4 w[16];
#pragma unroll
        for (int k = 0; k < 16; ++k) w[k] = *(const f32x4*)(W + (size_t)(k0 + k) * 6144);
#pragma unroll
        for (int k4 = 0; k4 < 16; k4 += 4)
#pragma unroll
            for (int r = 0; r < 9; ++r) { const f32x4 sv = *(const LAS f32x4*)(sc + r * 1024 + k0 + k4);
                acc[r] += w[k4] * sv.x; acc[r] += w[k4 + 1] * sv.y; acc[r] += w[k4 + 2] * sv.z; acc[r] += w[k4 + 3] * sv.w; }
    }
    float* mp = (float*)(WSP() + WS_MODP) + (size_t)kc * 4 * 9 * 6144;
#pragma unroll
    for (int r = 0; r < 9; ++r) *(f32x4*)(mp + ((size_t)l * 9 + r) * 6144 + cc * 256 + F.lane * 4) = acc[r];
}
__device__ __forceinline__ void mod_combine(const Frame& F) {
    const int gt = F.vcu * 512 + F.tid, NT = F.G * 512;
    const float* mp = (const float*)(WSP() + WS_MODP); float* modb = (float*)(WSP() + WS_MOD);
    for (int i = gt; i < 4 * 9 * 6144; i += NT) { const int l = i / (9 * 6144), c = i % 6144;
        float v[16];
#pragma unroll
        for (int k = 0; k < 16; ++k) v[k] = mp[i + (size_t)k * 4 * 9 * 6144];
#pragma unroll
        for (int k = 0; k < 8; ++k) v[k] += v[k + 8];
#pragma unroll
        for (int k = 0; k < 4; ++k) v[k] += v[k + 4];
        modb[i] = ((v[0] + v[2]) + (v[1] + v[3])) + INP(I_BMOD)[l * 6144 + c]; }
}

__device__ __forceinline__ void p1_kfull(const Frame& F) {
    const f32x2* powt = (const f32x2*)(WSP() + WS_POW); const f32x2* bbar = (const f32x2*)(WSP() + WS_BBAR);
    float* kf = (float*)(WSP() + WS_KFULL);
    LAS float* CR = (LAS float*)F.lds; LAS float* CI = CR + 2048; LAS float* BR = CI + 2048; LAS float* BI = BR + 2048;
    LAS float* PR = BI + 2048; LAS float* PI = PR + 2 * 33 * 64;
    for (int it = F.vcu; it < 256; it += F.G) {
        const int l = it >> 6, g = (it >> 1) & 31, half = it & 1;
        __syncthreads();
        for (int i = F.tid; i < 2048; i += 512) { const int dir = i >> 10, p = (i >> 4) & 63, h = i & 15, base = (l * 2 + dir) * 32 + g;
            CR[i] = INP(I_CRE)[(base * 16 + h) * 64 + p]; CI[i] = INP(I_CIM)[(base * 16 + h) * 64 + p];
            const f32x2 bb = bbar[(base * 64 + p) * 16 + h]; BR[i] = bb.x; BI[i] = bb.y; }
        for (int i = F.tid; i < 2 * 64 * 33; i += 512) { const int dir = i / (64 * 33), r = i % (64 * 33), p = r / 33, k = r % 33, base = (l * 2 + dir) * 32 + g;
            const f32x2 pw = powt[(size_t)(base * 64 + p) * 33 + k]; PR[(dir * 33 + k) * 64 + p] = pw.x; PI[(dir * 33 + k) * 64 + p] = pw.y; }
        __syncthreads();
        for (int task = half * 512 + F.tid; task < (half ? 63 * 16 : 512); task += 512) {
            const int li = task >> 4, hb = (task >> 2) & 3, hpb = task & 3, lag = li - 31;
            float acc[4][4];
#pragma unroll
            for (int i = 0; i < 4; ++i)
#pragma unroll
                for (int j = 0; j < 4; ++j) acc[i][j] = 0.f;
#pragma unroll
            for (int dir = 0; dir < 2; ++dir) {
                if ((dir == 0 && lag < 0) || (dir == 1 && lag > 0)) continue;
                const int k = lag < 0 ? -lag : lag;
                for (int p = 0; p < 64; ++p) {
                    const f32x4 cr = *(const LAS f32x4*)(CR + (dir * 64 + p) * 16 + 4 * hb), ci = *(const LAS f32x4*)(CI + (dir * 64 + p) * 16 + 4 * hb);
                    const f32x4 br = *(const LAS f32x4*)(BR + (dir * 64 + p) * 16 + 4 * hpb), bi = *(const LAS f32x4*)(BI + (dir * 64 + p) * 16 + 4 * hpb);
                    const float pr = PR[(dir * 33 + k) * 64 + p], pi = PI[(dir * 33 + k) * 64 + p];
#pragma unroll
                    for (int i = 0; i < 4; ++i) { const float wr = cr[i] * pr - ci[i] * pi, wi = cr[i] * pi + ci[i] * pr;
#pragma unroll
                        for (int j = 0; j < 4; ++j) acc[i][j] += wr * br[j] - wi * bi[j]; }
                }
            }
            if (lag == 0 && hb == hpb) {
#pragma unroll
                for (int i = 0; i < 4; ++i) acc[i][i] += INP(I_SSMD)[l * 512 + g * 16 + 4 * hb + i]; }
#pragma unroll
            for (int i = 0; i < 4; ++i) *(f32x4*)(kf + ((size_t)((l * 32 + g) * 63 + li) * 256 + (4 * hb + i) * 16 + 4 * hpb)) = (f32x4){acc[i][0], acc[i][1], acc[i][2], acc[i][3]};
        }
    }
    __syncthreads();
}

__device__ __forceinline__ void gen_w1(const Frame& F, int l) {
    const int gt = F.vcu * 512 + F.tid, NT = F.G * 512;
    const f32x2* powt = (const f32x2*)(WSP() + WS_POW); const f32x2* bbar = (const f32x2*)(WSP() + WS_BBAR);
    bf16* w1 = (bf16*)(WSP() + WS_W1);
    for (int i0 = gt; i0 < 32 * 256 * 64; i0 += 2 * NT) {
        f32x2 pw[2], bb[2][8]; size_t dst[2]; int ri[2]; bool ok[2];
#pragma unroll
        for (int k = 0; k < 2; ++k) { const int i = i0 + k * NT; ok[k] = i < 32 * 256 * 64; const int ii_ = ok[k] ? i : 0;
            const int k8 = ii_ & 63, n = (ii_ >> 6) & 255, g = ii_ >> 14, dir = n >> 7, p = (n & 127) >> 1, j = k8 >> 1, h0 = (k8 & 1) * 8;
            const int base = ((l * 2 + dir) * 32 + g) * 64 + p; ri[k] = n & 1;
            pw[k] = powt[(size_t)base * 33 + (dir == 0 ? 31 - j : j)];
#pragma unroll
            for (int e = 0; e < 8; ++e) bb[k][e] = bbar[base * 16 + h0 + e];
            dst[k] = (size_t)(g * 256 + n) * 512 + k8 * 8; }
#pragma unroll
        for (int k = 0; k < 2; ++k) if (ok[k]) { float v[8];
#pragma unroll
            for (int e = 0; e < 8; ++e) v[e] = ri[k] == 0 ? (pw[k].x * bb[k][e].x - pw[k].y * bb[k][e].y) : (pw[k].x * bb[k][e].y + pw[k].y * bb[k][e].x);
            u32x4 o; o.x = pk_bf16(v[0], v[1]); o.y = pk_bf16(v[2], v[3]); o.z = pk_bf16(v[4], v[5]); o.w = pk_bf16(v[6], v[7]); *(u32x4*)(w1 + dst[k]) = o; }
    }
}
__device__ __forceinline__ void gen_bty(const Frame& F, int l, int gt, int NT) {
    const f32x2* powt = (const f32x2*)(WSP() + WS_POW); const float* kf = (const float*)(WSP() + WS_KFULL);
    bf16* bty = (bf16*)(WSP() + WS_BTY);
    for (int i0 = gt; i0 < 32 * 512 * 64; i0 += 4 * NT) {
        f32x4 a[4], b[4]; size_t dst[4]; bool ok[4];
#pragma unroll
        for (int k = 0; k < 4; ++k) { const int i = i0 + k * NT; ok[k] = i < 32 * 512 * 64; const int ii_ = ok[k] ? i : 0;
            const int k8 = ii_ & 63, q = ii_ >> 6, n = q & 511, g = q >> 9, ii = n >> 4, h = n & 15, j = k8 >> 1, h0 = (k8 & 1) * 8;
            const float* src = kf + ((size_t)((l * 32 + g) * 63 + (ii - j + 31)) * 256 + h * 16 + h0);
            a[k] = *(const f32x4*)src; b[k] = *(const f32x4*)(src + 4); dst[k] = (size_t)(g * 512 + n) * 768 + k8 * 8; }
#pragma unroll
        for (int k = 0; k < 4; ++k) if (ok[k]) { u32x4 o; o.x = pk_bf16(a[k].x, a[k].y); o.y = pk_bf16(a[k].z, a[k].w); o.z = pk_bf16(b[k].x, b[k].y); o.w = pk_bf16(b[k].z, b[k].w); *(u32x4*)(bty + dst[k]) = o; }
    }
    for (int i0 = gt; i0 < 32 * 512 * 32; i0 += 2 * NT) {
        float cr[2][4], ci[2][4]; f32x2 pw[2][4]; size_t dst[2]; bool ok[2];
#pragma unroll
        for (int k = 0; k < 2; ++k) { const int i = i0 + k * NT; ok[k] = i < 32 * 512 * 32; const int ii_ = ok[k] ? i : 0;
            const int k8 = ii_ & 31, q = ii_ >> 5, n = q & 511, g = q >> 9, ii = n >> 4, h = n & 15, kk = k8 * 8, dir = kk >> 7, p0 = (kk & 127) >> 1, base = ((l * 2 + dir) * 32 + g);
#pragma unroll
            for (int e = 0; e < 4; ++e) { const int p = p0 + e; cr[k][e] = INP(I_CRE)[(base * 16 + h) * 64 + p]; ci[k][e] = INP(I_CIM)[(base * 16 + h) * 64 + p];
                pw[k][e] = powt[(size_t)(base * 64 + p) * 33 + (dir == 0 ? ii + 1 : 32 - ii)]; }
            dst[k] = (size_t)(g * 512 + n) * 768 + 512 + k8 * 8; }
#pragma unroll
        for (int k = 0; k < 2; ++k) if (ok[k]) { float v[8];
#pragma unroll
            for (int e = 0; e < 4; ++e) { v[2 * e] = cr[k][e] * pw[k][e].x - ci[k][e] * pw[k][e].y; v[2 * e + 1] = -(cr[k][e] * pw[k][e].y + ci[k][e] * pw[k][e].x); }
            u32x4 o; o.x = pk_bf16(v[0], v[1]); o.y = pk_bf16(v[2], v[3]); o.z = pk_bf16(v[4], v[5]); o.w = pk_bf16(v[6], v[7]); *(u32x4*)(bty + dst[k]) = o; }
    }
}

struct NpArgs {
    const void* xin_lat; const void* xin_ctx; void* xout_lat; void* xout_ctx;
    const bf16* ysrc;
    const float* gate; int gate_off;
    const float* gA;
    const float* gB;
    const float* modh; int shift_off, scale_off;
    bf16* hout; unsigned char* hout8;
    int nrows;
    const float* wrouter; const float* brouter; unsigned* cursor; unsigned char* tokrec; int* slottok;
    const LAS int* ebase;
};
template <int YSRC  , bool HOUT, bool ROUTE, int H8  , bool XI  , bool XO  >
__device__ __forceinline__ void norm_pass(const Frame& F, const NpArgs& P) {
    const int gw = F.vcu * 8 + F.wave, NGW = F.G * 8, lane = F.lane;
    const int rpw = (P.nrows + NGW - 1) / NGW;
    const int r0 = gw * rpw, r1 = (r0 + rpw) < P.nrows ? (r0 + rpw) : P.nrows;
    LAS float* wr_lds = (LAS float*)F.lds;
    LAS int* lcnt = (LAS int*)(F.lds + 32768);
    LAS int* rec = (LAS int*)(F.lds + 32768 + 64);
    if (ROUTE) {
        for (int i = F.tid; i < 8192; i += 512) wr_lds[i] = P.wrouter[i];
        if (F.tid < 16) lcnt[F.tid] = 0;
        __syncthreads();
    }
    f32x4 gAv[4], gBv[4], gatev[4], shiftv[4], scalev[4];
#pragma unroll
    for (int j = 0; j < 4; ++j) { const int c = 4 * lane + 256 * j;
        if (YSRC) gAv[j] = *(const f32x4*)(P.gA + c);
        if (HOUT) gBv[j] = *(const f32x4*)(P.gB + c); }
    float brt[8];
#pragma unroll
    for (int e = 0; e < 8; ++e) brt[e] = ROUTE ? P.brouter[e] : 0.f;
    int cur_rc = -1;
#define NP_LOAD(ROW, X, YA, YB, W0, W1) do { const int row_ = (ROW); const bool lat_ = row_ < TL; \
        if (XI) { const bf16* xin_ = lat_ ? ((const bf16*)P.xin_lat + (size_t)row_ * D) : ((const bf16*)P.xin_ctx + (size_t)(row_ - TL) * D); \
            _Pragma("unroll") for (int j = 0; j < 4; ++j) X##r[j] = *(const u32x2*)(xin_ + 4 * lane + 256 * j); }   \
        else { const float* xin_ = lat_ ? ((const float*)P.xin_lat + (size_t)row_ * D) : ((const float*)P.xin_ctx + (size_t)(row_ - TL) * D); \
            _Pragma("unroll") for (int j = 0; j < 4; ++j) X[j] = *(const f32x4*)(xin_ + 4 * lane + 256 * j); } \
        if (YSRC == 1) { _Pragma("unroll") for (int j = 0; j < 4; ++j) YA[j] = *(const u32x2*)(P.ysrc + (size_t)row_ * D + 4 * lane + 256 * j); } \
        if (YSRC == 2) { const u32x4 t4_ = trq4; const u32x2 t2_ = trq2;         \
            W0 = __uint_as_float(t2_.x); W1 = __uint_as_float(t2_.y); const size_t s0_ = (size_t)(P.ebase[(int)t4_.x] + (int)t4_.y), s1_ = (size_t)(P.ebase[(int)t4_.z] + (int)t4_.w); \
            _Pragma("unroll") for (int j = 0; j < 4; ++j) { YA[j] = *(const u32x2*)(P.ysrc + s0_ * D + 4 * lane + 256 * j); YB[j] = *(const u32x2*)(P.ysrc + s1_ * D + 4 * lane + 256 * j); } } } while (0)
#define NP_TREC(ROW) do { if (YSRC == 2) { const int* tr_ = (const int*)(P.tokrec + (size_t)(ROW) * 32); trq4 = *(const u32x4*)tr_; trq2 = *(const u32x2*)(tr_ + 4); } } while (0)
    u32x4 trq4 = {0u, 0u, 0u, 0u}; u32x2 trq2 = {0u, 0u};
    f32x4 xn[4]; u32x2 xnr[4], yan[4], ybn[4]; float w0n = 0.f, w1n = 0.f;
    f32x4 xm[4]; u32x2 xmr[4], yam[4], ybm[4]; float w0m = 0.f, w1m = 0.f;
    if (r0 < r1) { NP_TREC(r0); NP_LOAD(r0, xn, yan, ybn, w0n, w1n); }
    if (r0 + 1 < r1) { NP_TREC(r0 + 1); NP_LOAD(r0 + 1, xm, yam, ybm, w0m, w1m); }
    if (r0 + 2 < r1) NP_TREC(r0 + 2);
    for (int row = r0; row < r1; ++row) {
        const bool lat = row < TL; const int rc = lat ? (row >> 12) : 8;
        if (rc != cur_rc) { cur_rc = rc;
#pragma unroll
            for (int j = 0; j < 4; ++j) { const int c = 4 * lane + 256 * j;
                if (YSRC) gatev[j] = *(const f32x4*)(P.gate + (size_t)rc * 6144 + P.gate_off + c);
                if (HOUT) { shiftv[j] = *(const f32x4*)(P.modh + (size_t)rc * 6144 + P.shift_off + c); scalev[j] = *(const f32x4*)(P.modh + (size_t)rc * 6144 + P.scale_off + c); } } }
        f32x4 x[4]; u32x2 ya[4], yb[4]; const float w0 = w0n, w1 = w1n;
#pragma unroll
        for (int j = 0; j < 4; ++j) { if (XI) x[j] = (f32x4){bf_lo(xnr[j].x), bf_hi(xnr[j].x), bf_lo(xnr[j].y), bf_hi(xnr[j].y)}; else x[j] = xn[j]; ya[j] = yan[j]; yb[j] = ybn[j]; }
#pragma unroll
        for (int j = 0; j < 4; ++j) { xn[j] = xm[j]; xnr[j] = xmr[j]; yan[j] = yam[j]; ybn[j] = ybm[j]; }
        w0n = w0m; w1n = w1m;
        if (row + 2 < r1) NP_LOAD(row + 2, xm, yam, ybm, w0m, w1m);
        if (row + 3 < r1) NP_TREC(row + 3);
        if (YSRC) {
            f32x4 y[4];
            if (YSRC == 1) {
#pragma unroll
                for (int j = 0; j < 4; ++j) y[j] = (f32x4){bf_lo(ya[j].x), bf_hi(ya[j].x), bf_lo(ya[j].y), bf_hi(ya[j].y)};
            } else {
#pragma unroll
                for (int j = 0; j < 4; ++j) y[j] = (f32x4){w0 * bf_lo(ya[j].x) + w1 * bf_lo(yb[j].x), w0 * bf_hi(ya[j].x) + w1 * bf_hi(yb[j].x), w0 * bf_lo(ya[j].y) + w1 * bf_lo(yb[j].y), w0 * bf_hi(ya[j].y) + w1 * bf_hi(yb[j].y)};
            }
            float ss = 0.f;
#pragma unroll
            for (int j = 0; j < 4; ++j) ss += (y[j].x * y[j].x + y[j].y * y[j].y) + (y[j].z * y[j].z + y[j].w * y[j].w);
            const float rs = 1.0f / sqrtf(wave_sum(ss) * (1.0f / D) + RMS_EPS);
#pragma unroll
            for (int j = 0; j < 4; ++j) { x[j] = x[j] + gatev[j] * (y[j] * rs * gAv[j]);
                if (XO) { bf16* xo = lat ? ((bf16*)P.xout_lat + (size_t)row * D) : ((bf16*)P.xout_ctx + (size_t)(row - TL) * D); u32x2 w; w.x = pk_bf16(x[j].x, x[j].y); w.y = pk_bf16(x[j].z, x[j].w); *(u32x2*)(xo + 4 * lane + 256 * j) = w;
                    x[j] = (f32x4){bf_lo(w.x), bf_hi(w.x), bf_lo(w.y), bf_hi(w.y)}; }
                else { float* xo = lat ? ((float*)P.xout_lat + (size_t)row * D) : ((float*)P.xout_ctx + (size_t)(row - TL) * D); *(f32x4*)(xo + 4 * lane + 256 * j) = x[j]; } }
        }
        if (HOUT) {
            float ss = 0.f;
#pragma unroll
            for (int j = 0; j < 4; ++j) ss += (x[j].x * x[j].x + x[j].y * x[j].y) + (x[j].z * x[j].z + x[j].w * x[j].w);
            const float rs = 1.0f / sqrtf(wave_sum(ss) * (1.0f / D) + RMS_EPS);
            f32x4 hv[4];
#pragma unroll
            for (int j = 0; j < 4; ++j) { hv[j] = (x[j] * rs * gBv[j]) * (1.0f + scalev[j]) + shiftv[j];
                if (H8 == 1) *(unsigned*)((unsigned char*)P.hout + (size_t)row * D + 4 * lane + 256 * j) = pk_fp8x4(hv[j].x, hv[j].y, hv[j].z, hv[j].w);
                if (H8 == 2) *(unsigned*)(P.hout8 + (size_t)row * D + 4 * lane + 256 * j) = pk_fp8x4(hv[j].x, hv[j].y, hv[j].z, hv[j].w);
                if (H8 != 1) { u32x2 w; w.x = pk_bf16(hv[j].x, hv[j].y); w.y = pk_bf16(hv[j].z, hv[j].w); *(u32x2*)(P.hout + (size_t)row * D + 4 * lane + 256 * j) = w; } }
            if (ROUTE) {
                float lg[8];
#pragma unroll
                for (int e = 0; e < 8; ++e) lg[e] = 0.f;
#pragma unroll
                for (int j = 0; j < 4; ++j)
#pragma unroll
                    for (int c = 0; c < 4; ++c) { const int col = 4 * lane + 256 * j + c; const f32x4 wa = *(const LAS f32x4*)(wr_lds + col * 8), wb = *(const LAS f32x4*)(wr_lds + col * 8 + 4); const float hh = hv[j][c];
                        lg[0] += hh * wa.x; lg[1] += hh * wa.y; lg[2] += hh * wa.z; lg[3] += hh * wa.w; lg[4] += hh * wb.x; lg[5] += hh * wb.y; lg[6] += hh * wb.z; lg[7] += hh * wb.w; }
#pragma unroll
                for (int e = 0; e < 8; ++e) lg[e] = wave_sum(lg[e]) + brt[e];
                int e0 = 0; float v0 = lg[0];
#pragma unroll
                for (int e = 1; e < 8; ++e) if (lg[e] > v0) { v0 = lg[e]; e0 = e; }
                int e1 = -1; float v1 = -3.0e38f;
#pragma unroll
                for (int e = 0; e < 8; ++e) if (e != e0 && lg[e] > v1) { v1 = lg[e]; e1 = e; }
                const float w0 = 1.0f / (1.0f + expf(v1 - v0)), w1 = 1.0f - w0;
                if (lane == 0) {
                    const int p0 = __hip_atomic_fetch_add(&lcnt[e0], 1, __ATOMIC_RELAXED, __HIP_MEMORY_SCOPE_WORKGROUP), p1 = __hip_atomic_fetch_add(&lcnt[e1], 1, __ATOMIC_RELAXED, __HIP_MEMORY_SCOPE_WORKGROUP);
                    LAS int* rr = rec + (F.wave * rpw + (row - r0)) * 8;
                    rr[0] = row; rr[1] = e0; rr[2] = p0; rr[3] = e1; rr[4] = p1; rr[5] = __float_as_int(w0); rr[6] = __float_as_int(w1);
                }
            }
        }
    }
#undef NP_LOAD
#undef NP_TREC
    if (ROUTE) {
        __syncthreads();
        if (F.tid < 8) lcnt[8 + F.tid] = (int)__hip_atomic_fetch_add(P.cursor + 64 * F.tid, (unsigned)lcnt[F.tid], RLX_AGENT);
        __syncthreads();
        for (int i = F.tid; i < 8 * rpw; i += 512) {
            const int w = i / rpw, k = i % rpw; const int wr0 = (F.vcu * 8 + w) * rpw; if (wr0 + k >= P.nrows) continue;
            const LAS int* rr = rec + i * 8; const int row = rr[0], e0 = rr[1], e1 = rr[3]; const int p0 = rr[2] + lcnt[8 + e0], p1 = rr[4] + lcnt[8 + e1];
            int* tr = (int*)(P.tokrec + (size_t)row * 32); tr[0] = e0; tr[1] = p0; tr[2] = e1; tr[3] = p1; tr[4] = rr[5]; tr[5] = rr[6];
            P.slottok[(size_t)e0 * TT + p0] = row; P.slottok[(size_t)e1 * TT + p1] = row;
        }
        __syncthreads();
    }
}

__device__ __forceinline__ int moe_tables(const Frame& F, const gu32* cursor, LAS int* ebase  , LAS int* tile_e  ) {
    __syncthreads();
    if (F.tid == 0) { int b = 0; for (int e = 0; e < 8; ++e) { const int c = (int)__hip_atomic_load(cursor + 64 * e, RLX_AGENT); ebase[e] = b; ebase[8 + e] = c; const int nt = (c + 255) >> 8; for (int t = 0; t < nt; ++t) if ((b >> 8) + t < MOE_MAXTILES) tile_e[(b >> 8) + t] = e; b += nt << 8; } ebase[16] = b >> 8; }
    __syncthreads();
    int nt = ebase[16]; return nt > MOE_MAXTILES ? MOE_MAXTILES : nt;
}

__device__ __forceinline__ void moe_gather(const Frame& F, const LAS int* ebase, int ntiles, const int* slottok, const bf16* hb, bf16* asort, bool f8) {
    const int gw = F.vcu * 8 + F.wave, NGW = F.G * 8, nslot = ntiles * 256;
    const size_t rb = f8 ? (size_t)D : (size_t)2 * D;
    for (int s0 = gw; s0 < nslot; s0 += 4 * NGW) {
        int tok[4]; bool ok[4];
#pragma unroll
        for (int k = 0; k < 4; ++k) { const int s = s0 + k * NGW; ok[k] = s < nslot; tok[k] = 0;
            if (ok[k]) { int e = 0;
#pragma unroll
                for (int q = 1; q < 8; ++q) e += (s >= ebase[q]) ? 1 : 0;
                const int pos = s - ebase[e]; ok[k] = pos < ebase[8 + e]; if (ok[k]) tok[k] = slottok[(size_t)e * TT + pos]; } }
        u32x4 a[4], b[4];
#pragma unroll
        for (int k = 0; k < 4; ++k) if (ok[k]) { const u32x4* src = (const u32x4*)((const unsigned char*)hb + (size_t)tok[k] * rb); a[k] = src[F.lane]; if (!f8) b[k] = src[64 + F.lane]; }
#pragma unroll
        for (int k = 0; k < 4; ++k) if (ok[k]) { u32x4* dst = (u32x4*)((unsigned char*)asort + (size_t)(s0 + k * NGW) * rb); dst[F.lane] = a[k]; if (!f8) dst[64 + F.lane] = b[k]; }
    }
}

constexpr int KS_PITCH = 144, ATT_KB = 64 * KS_PITCH, ATT_BUF = 2 * ATT_KB;
typedef short v4i16_t __attribute__((ext_vector_type(4)));
__device__ __forceinline__ int crow(int i, int h) { return (i & 3) + 8 * (i >> 2) + 4 * h; }
__device__ __forceinline__ bf16x8 pack8(const f32x16& x, int s) {
    u32x4 p; p.x = pk_bf16(x[8 * s + 0], x[8 * s + 1]); p.y = pk_bf16(x[8 * s + 2], x[8 * s + 3]); p.z = pk_bf16(x[8 * s + 4], x[8 * s + 5]); p.w = pk_bf16(x[8 * s + 6], x[8 * s + 7]);
    return __builtin_bit_cast(bf16x8, p);
}
#define MFMA32(a, b, c) __builtin_amdgcn_mfma_f32_32x32x16_bf16((a), (b), (c), 0, 0, 0)
__device__ __forceinline__ void attn_unit(const Frame& F, int unit, const bf16* QB, const bf16* KB, const bf16* VB, bf16* AO, const float* sink_l) {
    const int tid = F.tid, wid = F.wave, lane = F.lane, r = lane & 31, h = lane >> 5;
    const bool isctx = unit >= 512;
    int b, kvh, nb;
    if (!isctx) { b = unit >> 6; kvh = (unit >> 5) & 1; nb = unit & 31; } else { const int v = unit - 512; b = v >> 2; kvh = (v >> 1) & 1; nb = v & 1; }
    const int qtok0 = isctx ? (TL + b * CTXL + nb * 128) : (b * SEQ + nb * 128);
    const int ctxtok0 = TL + b * CTXL;
    const int hq = kvh * 4 + (wid >> 1);
    const int qrow0 = (wid & 1) * 64;
    bf16x8 qf[2][4];
#pragma unroll
    for (int qb = 0; qb < 2; ++qb)
#pragma unroll
        for (int ks = 0; ks < 4; ++ks) qf[qb][ks] = *(const bf16x8*)(QB + (size_t)(qtok0 + qrow0 + qb * 32 + r) * DATT + hq * 64 + ks * 16 + 8 * h);
    const float sinkv = sink_l[hq] * LOG2E;
    float m_[2] = {sinkv, sinkv}, l_[2]; l_[0] = l_[1] = (h == 0) ? 1.0f : 0.0f;
    f32x16 o[2][2];
#pragma unroll
    for (int i = 0; i < 16; ++i) { o[0][0][i] = 0.f; o[0][1][i] = 0.f; o[1][0][i] = 0.f; o[1][1][i] = 0.f; }
    const int lo = isctx ? 0 : (nb == 0 ? 2 : 0), hi = isctx ? 0 : (nb == 31 ? 4 : 6), total = (hi - lo) + 4;
    const int skey = tid >> 3, sch = tid & 7;
    u32x4 kreg, vreg;
    auto tile_tok = [&](int idx) -> int { const int tt = lo + idx; return (tt >= hi) ? (ctxtok0 + 64 * (tt - hi)) : (b * SEQ + (nb - 1) * 128 + 64 * tt); };
    { const int kt = tile_tok(0); kreg = *(const u32x4*)(KB + (size_t)(kt + skey) * DKV + kvh * 64 + sch * 8); vreg = *(const u32x4*)(VB + (size_t)(kt + skey) * DKV + kvh * 64 + sch * 8); }
    auto stage_write = [&](int buf) {
        LAS unsigned char* kb_ = F.lds + buf * ATT_BUF; LAS unsigned char* vb_ = kb_ + ATT_KB;
        *(LAS u32x4*)(kb_ + skey * KS_PITCH + sch * 16) = kreg;
        *(LAS u32x4*)(vb_ + skey * KS_PITCH + sch * 16) = vreg;
    };
    __syncthreads();
    stage_write(0);
    __syncthreads();
    for (int idx = 0; idx < total; ++idx) {
        const int tt = lo + idx, buf = idx & 1;
        if (idx + 1 < total) { const int kt = tile_tok(idx + 1); kreg = *(const u32x4*)(KB + (size_t)(kt + skey) * DKV + kvh * 64 + sch * 8); vreg = *(const u32x4*)(VB + (size_t)(kt + skey) * DKV + kvh * 64 + sch * 8); }
        const LAS unsigned char* kbuf = F.lds + buf * ATT_BUF; const LAS unsigned char* vbuf = kbuf + ATT_KB;
        const int mtype = (tt < hi) ? (tt < 2 ? 1 : (tt >= 4 ? 2 : 0)) : 0;
        bf16x8 kf[2][4];
#pragma unroll
        for (int kb = 0; kb < 2; ++kb)
#pragma unroll
            for (int ks = 0; ks < 4; ++ks) kf[kb][ks] = *(const LAS bf16x8*)(kbuf + (32 * kb + r) * KS_PITCH + (16 * ks + 8 * h) * 2);
        bf16x8 pk[2][2][2];
#pragma unroll
        for (int qb = 0; qb < 2; ++qb) {
            f32x16 s[2];
            const float nref = -m_[qb];
#pragma unroll
            for (int i = 0; i < 16; ++i) { s[0][i] = nref; s[1][i] = nref; }
#pragma unroll
            for (int ks = 0; ks < 4; ++ks) { s[0] = MFMA32(kf[0][ks], qf[qb][ks], s[0]); s[1] = MFMA32(kf[1][ks], qf[qb][ks], s[1]); }
            const int iq = qrow0 + 32 * qb + r;
            float ls = 0.f;
            if (mtype == 1) {
                asm volatile("");
                const int thr = iq - 64 * tt - 4 * h;
#pragma unroll
                for (int kb = 0; kb < 2; ++kb)
#pragma unroll
                    for (int i = 0; i < 16; ++i) { const float p = (32 * kb + (i & 3) + 8 * (i >> 2) >= thr) ? fast_exp2(s[kb][i]) : 0.f; s[kb][i] = p; ls += p; }
            } else if (mtype == 2) {
                asm volatile("");
                const int thr = iq - 64 * (tt - 4) - 4 * h;
#pragma unroll
                for (int kb = 0; kb < 2; ++kb)
#pragma unroll
                    for (int i = 0; i < 16; ++i) { const float p = (32 * kb + (i & 3) + 8 * (i >> 2) <= thr) ? fast_exp2(s[kb][i]) : 0.f; s[kb][i] = p; ls += p; }
            } else {
#pragma unroll
                for (int kb = 0; kb < 2; ++kb)
#pragma unroll
                    for (int i = 0; i < 16; ++i) { const float p = fast_exp2(s[kb][i]); s[kb][i] = p; ls += p; }
            }
            l_[qb] += ls;
#pragma unroll
            for (int kb = 0; kb < 2; ++kb) { pk[qb][kb][0] = pack8(s[kb], 0); pk[qb][kb][1] = pack8(s[kb], 1); }
        }
#pragma unroll
        for (int kb = 0; kb < 2; ++kb)
#pragma unroll
            for (int st = 0; st < 2; ++st)
#pragma unroll
                for (int db = 0; db < 2; ++db) {
                    const LAS unsigned char* vp = vbuf + (32 * kb + 16 * st + 4 * h + ((lane & 15) >> 2)) * KS_PITCH + (32 * db + 16 * ((lane >> 4) & 1) + 4 * (lane & 3)) * 2;
                    const s16x4 vlo = __builtin_bit_cast(s16x4, __builtin_amdgcn_ds_read_tr16_b64_v4i16((LAS v4i16_t*)vp));
                    const s16x4 vhi = __builtin_bit_cast(s16x4, __builtin_amdgcn_ds_read_tr16_b64_v4i16((LAS v4i16_t*)(vp + 8 * KS_PITCH)));
                    const bf16x8 vf = __builtin_shufflevector(vlo, vhi, 0, 1, 2, 3, 4, 5, 6, 7);
                    o[db][0] = MFMA32(vf, pk[0][kb][st], o[db][0]); o[db][1] = MFMA32(vf, pk[1][kb][st], o[db][1]);
                }
        if (idx + 1 < total) stage_write(buf ^ 1);
        __syncthreads();
    }
#pragma unroll
    for (int qb = 0; qb < 2; ++qb) {
        const float lt = l_[qb] + __int_as_float(__builtin_amdgcn_ds_bpermute((F.lane ^ 32) << 2, __float_as_int(l_[qb]))); const float inv = 1.0f / lt;
        bf16* orow = AO + (size_t)(qtok0 + qrow0 + qb * 32 + r) * DATT + hq * 64;
#pragma unroll
        for (int db = 0; db < 2; ++db)
#pragma unroll
            for (int g4 = 0; g4 < 4; ++g4) { u32x2 w; w.x = pk_bf16(o[db][qb][4 * g4] * inv, o[db][qb][4 * g4 + 1] * inv); w.y = pk_bf16(o[db][qb][4 * g4 + 2] * inv, o[db][qb][4 * g4 + 3] * inv);
                *(u32x2*)(orow + 32 * db + 8 * g4 + 4 * h) = w; }
    }
}

__device__ __forceinline__ void ssm_carry(const Frame& F, int l) {
    const f32x2* powt = (const f32x2*)(WSP() + WS_POW); const float* ef = (const float*)(WSP() + WS_EF); bf16* ag = (bf16*)(WSP() + WS_AG);
    LAS f32x2* tot = (LAS f32x2*)F.lds;
    const int p = F.lane;
    for (int bg = F.vcu; bg < NB * NG; bg += F.G) {
        const int b = bg >> 5, g = bg & 31, rowb = g * SSM_RPAD + b * NCHUNK, seg = F.wave;
        f32x2 lin[2][17]; f32x2 lam32[2];
#define CARRY_C(dir, step) (((dir) == 0) ? (step) : ((step) < 8 ? 7 - (step) : 143 - (step)))
        __syncthreads();
#pragma unroll
        for (int dir = 0; dir < 2; ++dir) {
            const f32x2 lam = powt[(size_t)(((l * 2 + dir) * 32 + g) * 64 + p) * 33 + 32]; lam32[dir] = lam;
            f32x2 e[17];
#pragma unroll
            for (int k = 0; k < 17; ++k) e[k] = *(const f32x2*)(ef + (size_t)(rowb + CARRY_C(dir, seg * 17 + k)) * 256 + dir * 128 + 2 * p);
            float sr = 0.f, si = 0.f;
#pragma unroll
            for (int k = 0; k < 17; ++k) { lin[dir][k] = (f32x2){sr, si}; const float nr = lam.x * sr - lam.y * si + e[k].x, ni = lam.x * si + lam.y * sr + e[k].y; sr = nr; si = ni; }
            tot[(dir * 8 + seg) * 64 + p] = (f32x2){sr, si};
        }
        __syncthreads();
#pragma unroll
        for (int dir = 0; dir < 2; ++dir) {
            const f32x2 lam = lam32[dir];
            f32x2 A = (f32x2){1.f, 0.f};
#pragma unroll
            for (int k = 0; k < 17; ++k) A = (f32x2){A.x * lam.x - A.y * lam.y, A.x * lam.y + A.y * lam.x};
            float sr = 0.f, si = 0.f;
            for (int s2 = 0; s2 < seg; ++s2) { const f32x2 t = tot[(dir * 8 + s2) * 64 + p]; const float nr = A.x * sr - A.y * si + t.x, ni = A.x * si + A.y * sr + t.y; sr = nr; si = ni; }
            float mr = 1.f, mi = 0.f;
#pragma unroll
            for (int k = 0; k < 17; ++k) {
                const float vr = lin[dir][k].x + (mr * sr - mi * si), vi = lin[dir][k].y + (mr * si + mi * sr);
                *(unsigned*)(ag + (size_t)(rowb + CARRY_C(dir, seg * 17 + k)) * AG_PITCH + 512 + dir * 128 + 2 * p) = pk_bf16(vr, vi);
                const float nr = mr * lam.x - mi * lam.y, ni = mr * lam.y + mi * lam.x; mr = nr; mi = ni; }
        }
#undef CARRY_C
    }
    gen_bty(F, l, F.vcu * 512 + F.tid, F.G * 512);
}

struct OpsDense { int K, lda, ldb; const char* A; const char* B; int wscale;
    __device__ __forceinline__ unsigned a_off(const Unit& u) const { return (unsigned)u.pm * 256u * (unsigned)lda; }
    __device__ __forceinline__ unsigned b_off(const Unit& u) const { return (unsigned)u.pn * 256u * (unsigned)ldb; } };
struct OpsGroup { int K, lda, ldb; const char* A; const char* B; size_t a_g, b_g; int wscale;
    __device__ __forceinline__ unsigned a_off(const Unit& u) const { return (unsigned)u.g * (unsigned)a_g + (unsigned)u.pm * 256u * (unsigned)lda; }
    __device__ __forceinline__ unsigned b_off(const Unit& u) const { return (unsigned)u.g * (unsigned)b_g + (unsigned)u.pn * 256u * (unsigned)ldb; } };
struct OpsMoe { int K, lda, ldb; const char* A; const char* B; size_t b_g; int wscale;
    __device__ __forceinline__ unsigned a_off(const Unit& u) const { return (unsigned)u.pm * 256u * (unsigned)lda; }
    __device__ __forceinline__ unsigned b_off(const Unit& u) const { return (unsigned)u.g * (unsigned)b_g + (unsigned)u.pn * 256u * (unsigned)ldb; } };

typedef const f32x4 (&AccRef)[2][2][4][2];
#define EPI_ROWS(ai, m) (u.pm * 256 + (ai) * 128 + wr * 64 + (m) * 16 + fr)
__device__ __forceinline__ u32x4 pack_row8(const f32x4& v0, const f32x4& v1) { u32x4 w; w.x = pk_bf16(v0[0], v0[1]); w.y = pk_bf16(v0[2], v0[3]); w.z = pk_bf16(v1[0], v1[1]); w.w = pk_bf16(v1[2], v1[3]); return w; }
__device__ __forceinline__ void unpack8(const u32x4& w, f32x4& a, f32x4& b) { a = (f32x4){bf_lo(w.x), bf_hi(w.x), bf_lo(w.y), bf_hi(w.y)}; b = (f32x4){bf_lo(w.z), bf_hi(w.z), bf_lo(w.w), bf_hi(w.w)}; }
#ifndef EPI_WT
#define EPI_WT 0
#endif
__device__ __forceinline__ void st16(void* base, unsigned off, const u32x4& v) {
#if EPI_WT
    asm volatile("global_store_dwordx4 %0, %1, %2 sc1\n\ts_nop 1" :: "v"(off), "v"(v), "s"(base) : "memory");
#else
    *(u32x4*)((char*)base + off) = v;
#endif
}
__device__ __forceinline__ void st16f(void* base, unsigned off, const f32x4& v) { *(f32x4*)((char*)base + off) = v; }
__device__ __forceinline__ u32x4 ld16(const void* base, unsigned off) { return *(const u32x4*)((const char*)base + off); }
__device__ __forceinline__ f32x4 ld16f(const void* base, unsigned off) { return *(const f32x4*)((const char*)base + off); }

struct EpiIn {
    static constexpr bool PERM = true;
    bf16 *QB, *KB, *VB, *AG; const float* ropec; const float* ropes;
    __device__ __forceinline__ void operator()(AccRef acc, const Unit& u, int wr, int wc, int fr, int fq) const {
        const unsigned cq = wc * 32 + 8 * fq; const bool lat = u.pm < 128;
#define ROPE8(v0, v1, cc, ss) do { const f32x4 a0_ = v0, a1_ = v1; \
            v0[0] = a0_[0] * cc[0] - a0_[1] * ss[0]; v0[1] = a0_[1] * cc[0] + a0_[0] * ss[0]; v0[2] = a0_[2] * cc[1] - a0_[3] * ss[1]; v0[3] = a0_[3] * cc[1] + a0_[2] * ss[1]; \
            v1[0] = a1_[0] * cc[2] - a1_[1] * ss[2]; v1[1] = a1_[1] * cc[2] + a1_[0] * ss[2]; v1[2] = a1_[2] * cc[3] - a1_[3] * ss[3]; v1[3] = a1_[3] * cc[3] + a1_[2] * ss[3]; } while (0)
        if (u.pn <= 1) {
#pragma unroll
            for (int ai = 0; ai < 2; ++ai) {
                f32x4 c4[4][2], s4[4][2];
                if (lat) {
#pragma unroll
                    for (int m = 0; m < 4; ++m)
#pragma unroll
                        for (int bj = 0; bj < 2; ++bj) { const unsigned col = u.pn * 256 + bj * 128 + cq; const unsigned roff = ((((unsigned)EPI_ROWS(ai, m)) & 4095u) * 32 + ((col & 63u) >> 1)) * 4; c4[m][bj] = ld16f(ropec, roff); s4[m][bj] = ld16f(ropes, roff); }
                } else {
#pragma unroll
                    for (int m = 0; m < 4; ++m)
#pragma unroll
                        for (int bj = 0; bj < 2; ++bj) { c4[m][bj] = (f32x4){1.f, 1.f, 1.f, 1.f}; s4[m][bj] = (f32x4){0.f, 0.f, 0.f, 0.f}; }
                }
#pragma unroll
                for (int m = 0; m < 4; ++m)
#pragma unroll
                    for (int bj = 0; bj < 2; ++bj) { f32x4 v0 = acc[ai][bj][m][0], v1 = acc[ai][bj][m][1]; ROPE8(v0, v1, c4[m][bj], s4[m][bj]); v0 = v0 * QSCALE; v1 = v1 * QSCALE;
                        st16(QB, ((unsigned)EPI_ROWS(ai, m) * DATT + u.pn * 256 + bj * 128 + cq) * 2, pack_row8(v0, v1)); }
            }
        } else if (u.pn == 2) {
#pragma unroll
            for (int ai = 0; ai < 2; ++ai) {
                f32x4 c4[4], s4[4];
                if (lat) {
#pragma unroll
                    for (int m = 0; m < 4; ++m) { const unsigned roff = ((((unsigned)EPI_ROWS(ai, m)) & 4095u) * 32 + ((cq & 63u) >> 1)) * 4; c4[m] = ld16f(ropec, roff); s4[m] = ld16f(ropes, roff); }
                } else {
#pragma unroll
                    for (int m = 0; m < 4; ++m) { c4[m] = (f32x4){1.f, 1.f, 1.f, 1.f}; s4[m] = (f32x4){0.f, 0.f, 0.f, 0.f}; }
                }
#pragma unroll
                for (int m = 0; m < 4; ++m) { const unsigned tok = EPI_ROWS(ai, m);
                    f32x4 v0 = acc[ai][0][m][0], v1 = acc[ai][0][m][1]; ROPE8(v0, v1, c4[m], s4[m]);
                    st16(KB, (tok * DKV + cq) * 2, pack_row8(v0, v1));
                    st16(VB, (tok * DKV + cq) * 2, pack_row8(acc[ai][1][m][0], acc[ai][1][m][1])); }
            }
#undef ROPE8
        } else {
#pragma unroll
            for (int ai = 0; ai < 2; ++ai)
#pragma unroll
                for (int m = 0; m < 4; ++m) { const unsigned tok = EPI_ROWS(ai, m); unsigned rowag, ii;
                    if (lat) { const unsigned b = tok >> 12, t = tok & 4095u; rowag = b * NCHUNK + 8 + (t >> 5); ii = t & 31u; } else { const unsigned tc = tok - TL, b = tc >> 8, t = tc & 255u; rowag = b * NCHUNK + (t >> 5); ii = t & 31u; }
#pragma unroll
                    for (int bj = 0; bj < 2; ++bj) { const unsigned cu = (u.pn - 3) * 256 + bj * 128 + cq, g = cu >> 4, h0 = cu & 15u;
                        st16(AG, ((g * SSM_RPAD + rowag) * AG_PITCH + ii * 16 + h0) * 2, pack_row8(acc[ai][bj][m][0], acc[ai][bj][m][1])); } }
        }
    }
};
struct EpiGate {
    static constexpr bool PERM = true;
    bf16 *SGA, *SGB;
    __device__ __forceinline__ void operator()(AccRef acc, const Unit& u, int wr, int wc, int fr, int fq) const {
        bf16* base = (u.pn < 4) ? SGA : SGB; const unsigned c0 = (u.pn & 3) * 256 + wc * 32 + 8 * fq;
#pragma unroll
        for (int ai = 0; ai < 2; ++ai)
#pragma unroll
            for (int m = 0; m < 4; ++m) { const unsigned tok = EPI_ROWS(ai, m);
#pragma unroll
                for (int bj = 0; bj < 2; ++bj) { f32x4 v0 = acc[ai][bj][m][0], v1 = acc[ai][bj][m][1];
                    v0 = sigmoid4(v0); v1 = sigmoid4(v1);
                    st16(base, (tok * D + c0 + bj * 128) * 2, pack_row8(v0, v1)); } }
    }
};
struct EpiE {
    static constexpr bool PERM = false;
    float* EF;
    __device__ __forceinline__ void operator()(AccRef acc, const Unit& u, int wr, int wc, int fr, int fq) const {
#pragma unroll
        for (int ai = 0; ai < 2; ++ai)
#pragma unroll
            for (int m = 0; m < 4; ++m) { const unsigned ro = ((unsigned)(u.g * SSM_RPAD + EPI_ROWS(ai, m)) * 256 + wc * 32 + 4 * fq) * 4;
#pragma unroll
                for (int bj = 0; bj < 2; ++bj)
#pragma unroll
                    for (int n = 0; n < 2; ++n) st16f(EF, ro + (bj * 128 + n * 16) * 4, acc[ai][bj][m][n]); }
    }
};
struct EpiY {
    static constexpr bool PERM = true;
    bf16* GY;
    __device__ __forceinline__ void operator()(AccRef acc, const Unit& u, int wr, int wc, int fr, int fq) const {
#pragma unroll
        for (int ai = 0; ai < 2; ++ai)
#pragma unroll
            for (int m = 0; m < 4; ++m) { const unsigned rr = EPI_ROWS(ai, m); if (rr >= (unsigned)SSM_ROWS) continue; const unsigned b = rr / NCHUNK, c = rr % NCHUNK;
                const unsigned tokb = (c < 8) ? (TL + b * CTXL + c * 32) : (b * SEQ + (c - 8) * 32);
#pragma unroll
                for (int bj = 0; bj < 2; ++bj) { const unsigned col = u.pn * 256 + bj * 128 + wc * 32 + 8 * fq, ii = col >> 4, h0 = col & 15u; f32x4 v0 = acc[ai][bj][m][0], v1 = acc[ai][bj][m][1];
                    v0 = gelu4(v0); v1 = gelu4(v1);
                    st16(GY, ((tokb + ii) * DSSM + u.g * 16 + h0) * 2, pack_row8(v0, v1)); } }
    }
};
struct EpiGlu {
    static constexpr bool PERM = true;
    const bf16* GY; bf16* SB; const float* bias;
    __device__ __forceinline__ void operator()(AccRef acc, const Unit& u, int wr, int wc, int fr, int fq) const {
        f32x4 b0[2], b1[2];
#pragma unroll
        for (int bj = 0; bj < 2; ++bj) { const unsigned col = u.pn * 256 + bj * 128 + wc * 32 + 8 * fq; b0[bj] = ld16f(bias, col * 4); b1[bj] = ld16f(bias, col * 4 + 16); }
        u32x4 gy[2][4][2]; unsigned off[2][4][2];
#pragma unroll
        for (int ai = 0; ai < 2; ++ai)
#pragma unroll
            for (int m = 0; m < 4; ++m)
#pragma unroll
                for (int bj = 0; bj < 2; ++bj) { off[ai][m][bj] = ((unsigned)EPI_ROWS(ai, m) * DSSM + u.pn * 256 + bj * 128 + wc * 32 + 8 * fq) * 2; gy[ai][m][bj] = ld16(GY, off[ai][m][bj]); }
#pragma unroll
        for (int ai = 0; ai < 2; ++ai)
#pragma unroll
            for (int m = 0; m < 4; ++m)
#pragma unroll
                for (int bj = 0; bj < 2; ++bj) { f32x4 g0, g1; unpack8(gy[ai][m][bj], g0, g1);
                    f32x4 v0 = acc[ai][bj][m][0] + b0[bj], v1 = acc[ai][bj][m][1] + b1[bj];
                    v0 = g0 * sigmoid4(v0); v1 = g1 * sigmoid4(v1);
                    st16(SB, off[ai][m][bj], pack_row8(v0, v1)); }
    }
};
template <int MODE> struct EpiMerge {
    static constexpr bool PERM = true;
    const bf16* SG; const bf16* MIN; bf16* MB;
    __device__ __forceinline__ void operator()(AccRef acc, const Unit& u, int wr, int wc, int fr, int fq) const {
        u32x4 sg[2][4][2], mn[4][2]; unsigned off[2][4][2];
#pragma unroll
        for (int ai = 0; ai < 2; ++ai)
#pragma unroll
            for (int m = 0; m < 4; ++m)
#pragma unroll
                for (int bj = 0; bj < 2; ++bj) { off[ai][m][bj] = ((unsigned)EPI_ROWS(ai, m) * D + u.pn * 256 + bj * 128 + wc * 32 + 8 * fq) * 2; sg[ai][m][bj] = ld16(SG, off[ai][m][bj]); }
        if (MODE == 1) {
#pragma unroll
            for (int m = 0; m < 4; ++m)
#pragma unroll
                for (int bj = 0; bj < 2; ++bj) mn[m][bj] = ld16(MIN, off[0][m][bj]); }
#pragma unroll
        for (int ai = 0; ai < 2; ++ai) {
            u32x4 outv[4][2];
#pragma unroll
            for (int m = 0; m < 4; ++m)
#pragma unroll
                for (int bj = 0; bj < 2; ++bj) { f32x4 g0, g1; unpack8(sg[ai][m][bj], g0, g1);
                    f32x4 v0 = g0 * acc[ai][bj][m][0], v1 = g1 * acc[ai][bj][m][1];
                    if (MODE == 1) { f32x4 p0, p1; unpack8(mn[m][bj], p0, p1); v0 = v0 + p0; v1 = v1 + p1; }
                    outv[m][bj] = pack_row8(v0, v1); }
            if (MODE == 1 && ai == 0) {
#pragma unroll
                for (int m = 0; m < 4; ++m)
#pragma unroll
                    for (int bj = 0; bj < 2; ++bj) mn[m][bj] = ld16(MIN, off[1][m][bj]); }
#pragma unroll
            for (int m = 0; m < 4; ++m)
#pragma unroll
                for (int bj = 0; bj < 2; ++bj) st16(MB, off[ai][m][bj], outv[m][bj]);
        }
    }
};
struct EpiStore {
    static constexpr bool PERM = true;
    bf16* O; int ldc;
    __device__ __forceinline__ void operator()(AccRef acc, const Unit& u, int wr, int wc, int fr, int fq) const {
#pragma unroll
        for (int ai = 0; ai < 2; ++ai)
#pragma unroll
            for (int m = 0; m < 4; ++m)
#pragma unroll
                for (int bj = 0; bj < 2; ++bj) st16(O, ((unsigned)EPI_ROWS(ai, m) * ldc + u.pn * 256 + bj * 128 + wc * 32 + 8 * fq) * 2, pack_row8(acc[ai][bj][m][0], acc[ai][bj][m][1]));
    }
};
template <bool O8> struct EpiSwiglu {
    static constexpr bool PERM = true;
    unsigned char* O; int ldc; int t0;
    __device__ __forceinline__ void operator()(AccRef acc, const Unit& u, int wr, int wc, int fr, int fq) const {
#pragma unroll
        for (int ai = 0; ai < 2; ++ai)
#pragma unroll
            for (int m = 0; m < 4; ++m) { f32x4 v0 = acc[ai][0][m][0], v1 = acc[ai][0][m][1];
                v0 = (v0 * acc[ai][1][m][0]) * sigmoid4(v0); v1 = (v1 * acc[ai][1][m][1]) * sigmoid4(v1);
                const unsigned eo = (unsigned)(EPI_ROWS(ai, m) - 256 * t0) * (unsigned)ldc + u.pn * 128 + wc * 32 + 8 * fq;
                if (O8) { u32x2 w; w.x = pk_fp8x4_nc(v0[0], v0[1], v0[2], v0[3]); w.y = pk_fp8x4_nc(v1[0], v1[1], v1[2], v1[3]); *(u32x2*)(O + eo) = w; }
                else st16(O, eo * 2, pack_row8(v0, v1)); }
    }
};

__global__ void __launch_bounds__(512, 2) hybrid_fwd(Args args) {
    extern __shared__ __attribute__((aligned(16))) unsigned char lds_raw[];
    Frame F0;
#define F F0
    F.lds = (LAS unsigned char*)lds_raw;
    F.tid = threadIdx.x; F.lane = F.tid & 63; F.wave = __builtin_amdgcn_readfirstlane(F.tid >> 6);
    F.G = gridDim.x; { const int bx = blockIdx.x; F.vcu = (F.G % 8 == 0) ? (bx % 8) * (F.G / 8) + bx / 8 : bx; }
    volatile LAS unsigned* MISC = (volatile LAS unsigned*)(F.lds + MISC_OFF);
    for (int u = F.tid; u < 64; u += 512) MISC[u] = 0u;
    if (F.tid == 0) { volatile LAS unsigned long long* pt = (volatile LAS unsigned long long*)(F.lds + PTAB_OFF);
#pragma unroll
        for (int i = 0; i < 30; ++i) pt[i] = (unsigned long long)args.in[i];
        pt[30] = (unsigned long long)args.out; pt[31] = (unsigned long long)args.ws; }
    __syncthreads();
    { const XcdBarrier bar0 = xcd_barrier_post((unsigned*)(CTLP() + CW_BAR), MISC + 8); if (F.tid == 0) MISC[10] = bar0.x; }
    __syncthreads();
#define GRID_BAR() do { XcdBarrier b_; b_.bar = (unsigned*)((gu32*)((GAS unsigned char*)ptab_get(F0, 31) + WS_CTL) + CW_BAR); b_.x = MISC[10]; b_.st = MISC + 8; xcd_barrier(b_, F0.wave == 0 && ((__builtin_amdgcn_mbcnt_hi(~0u, __builtin_amdgcn_mbcnt_lo(~0u, 0u)) & 63u) == 0u)); } while (0)
    LAS int* tab_ebase = (LAS int*)(F.lds + TAB_OFF);
    LAS int* tab_tile = (LAS int*)(F.lds + TAB_OFF + 128);
    const int bid = (int)blockIdx.x;
#define ws WSP()
#define modb ((float*)(WSP() + WS_MOD))
#define HB ((bf16*)(WSP() + WS_HB))
#define XC ((float*)(WSP() + WS_XC))

#undef F
    { const Frame F = relaunder(F0);
    PH(0) mod_sc_init(F);
    RPT(1) { if (rep_) GRID_BAR(); PH(1) p0_tables(F); }
    RPT(2) { if (rep_) GRID_BAR(); PH(2) p0_weights(F); }
    }
    GRID_BAR();
    { const Frame F = relaunder(F0);
    RPT(3) { if (rep_) GRID_BAR(); PH(3) p1_kfull(F); }
    PH(0) mod_combine(F);
    }
    GRID_BAR();
    { const Frame F = relaunder(F0);
    RPT(4) { if (rep_) GRID_BAR(); PH(4) {
        NpArgs P{}; P.xin_lat = INP(I_X); P.xin_ctx = INP(I_CTX); P.xout_lat = OUTP(); P.xout_ctx = XC;
        P.gB = INP(I_NORMG) + (0 * 4 + 0) * D; P.modh = modb; P.shift_off = 0; P.scale_off = 1024; P.hout = HB; P.hout8 = ws + WS_H8; P.nrows = TT;
        norm_pass<0, true, false, 2, false, false>(F, P);
    } }
    }
    GRID_BAR();

    for (int l = 0; l < DEPTH; ++l) {
        const bool last = (l == DEPTH - 1);
        const bool f8 = (F8MASK >> l) & 1u;
        const int nM = last ? 128 : 136;

        { const Frame F = relaunder(F0);
            {
                OpsDense O{2 * D, 2 * D, 2 * D, (const char*)HB, (const char*)(ws + WS_WIN + (size_t)l * WIN_L), 0};
                pg8::DenseOrder S; S.init(136, 5, F.G, bid);
                EpiIn E{(bf16*)(ws + WS_QB), (bf16*)(ws + WS_KB), (bf16*)(ws + WS_VB), (bf16*)(ws + WS_AG), (const float*)(ws + WS_ROPE), (const float*)(ws + WS_ROPE) + 4096 * 32};
                RPT(5) { if (rep_) GRID_BAR(); PH(5) pg8::gemm_phase<0>(F.lds, F.wave, O, S, E); }
            }
            {
                OpsDense O{D, D, D, (const char*)(ws + WS_H8), (const char*)(ws + WS_WIN + (size_t)l * WIN_L + (size_t)NQKVU * D * 2), 0};
                pg8::DenseOrder S; S.init(136, 8, F.G, (bid + 88) % F.G);
                EpiGate E{(bf16*)(ws + WS_SGA), (bf16*)(ws + WS_SGB)};
                RPT(5) { if (rep_) GRID_BAR(); PH(5) pg8::gemm_phase<124>(F.lds, F.wave, O, S, E); }
            }
            RPT(6) { if (rep_) GRID_BAR(); PH(6) gen_w1(F, l); }
        }
        GRID_BAR();
        { const Frame F = relaunder(F0);
            OpsGroup O{1024, 2 * AG_PITCH, 1024, (const char*)(ws + WS_AG), (const char*)(ws + WS_W1), (size_t)SSM_RPAD * AG_PITCH * 2, (size_t)256 * 512 * 2, 0};
            pg8::GroupOrder S; S.init(NG, 5, 1, F.G, bid);
            EpiE E{(float*)(ws + WS_EF)};
            RPT(7) { if (rep_) GRID_BAR(); PH(7) pg8::gemm_phase<0>(F.lds, F.wave, O, S, E); }
            const int nunits = last ? 512 : 544;
            RPT(8) { if (rep_) GRID_BAR();
            gu32* qctr = CTLP() + CW_QUEUE + 64 * (l + 4 * rep_);
            for (;;) {
                __syncthreads();
                if (F.tid == 0) MISC[16] = __hip_atomic_fetch_add(qctr, 1u, RLX_AGENT);
                __syncthreads();
                const int unit = __builtin_amdgcn_readfirstlane((int)MISC[16]);
                if (unit >= nunits) break;
                PH(8) attn_unit(F, unit, (const bf16*)(ws + WS_QB), (const bf16*)(ws + WS_KB), (const bf16*)(ws + WS_VB), (bf16*)(ws + WS_AO), INP(I_SINK) + l * 8);
            }
            }
            bg_tail(F, l * 16 + 9, true, true, F.G - 24, l >> 1);
        }
        GRID_BAR();
        { const Frame F = relaunder(F0); RPT(9) { if (rep_) GRID_BAR(); PH(9) ssm_carry(F, l); } }
        GRID_BAR();
        { const Frame F = relaunder(F0);
            OpsGroup O{1536, 2 * AG_PITCH, 1536, (const char*)(ws + WS_AG), (const char*)(ws + WS_BTY), (size_t)SSM_RPAD * AG_PITCH * 2, (size_t)512 * 768 * 2, 0};
            pg8::GroupOrder S; S.init(NG, 5, 2, F.G, bid);
            EpiY E{(bf16*)(ws + WS_GY)};
            RPT(10) { if (rep_) GRID_BAR(); PH(10) pg8::gemm_phase<0>(F.lds, F.wave, O, S, E); }
        }
        { const Frame F = relaunder(F0);
            OpsDense O{1024, 1024, 1024, (const char*)(ws + WS_AO), (const char*)(ws + WS_WPA + (size_t)l * 1024 * 512 * 2), 0};
            pg8::DenseOrder S; S.init(nM, 4, F.G, bid, 1);
            EpiMerge<0> E{(const bf16*)(ws + WS_SGA), nullptr, (bf16*)(ws + WS_HB)};
            RPT(11) { if (rep_) GRID_BAR(); PH(11) pg8::gemm_phase<0>(F.lds, F.wave, O, S, E); }
        }
        GRID_BAR();
        { const Frame F = relaunder(F0);
            OpsDense O{1024, 1024, 1024, (const char*)(ws + WS_GY), (const char*)(ws + WS_WGLU + (size_t)l * 512 * 512 * 2), 0};
            pg8::DenseOrder S; S.init(nM, 2, F.G, bid);
            EpiGlu E{(const bf16*)(ws + WS_GY), (bf16*)(ws + WS_SB), INP(I_BGLU) + l * 512};
            RPT(12) { if (rep_) GRID_BAR(); PH(12) pg8::gemm_phase<0>(F.lds, F.wave, O, S, E, S.slack() ? -1 : CW_DONE + 64 * (l * 16 + 0)); }
            bg_tail(F, l * 16 + 0, false, S.slack(), 1, l >> 1);
        }
        GRID_BAR();
        { const Frame F = relaunder(F0);
            OpsDense O{1024, 1024, 1024, (const char*)(ws + WS_SB), (const char*)(ws + WS_WPB + (size_t)l * 1024 * 512 * 2), 0};
            pg8::DenseOrder S; S.init(nM, 4, F.G, bid);
            EpiMerge<1> E{(const bf16*)(ws + WS_SGB), (const bf16*)(ws + WS_HB), (bf16*)(ws + WS_MB)};
            RPT(13) { if (rep_) GRID_BAR(); PH(13) pg8::gemm_phase<0>(F.lds, F.wave, O, S, E, S.slack() ? -1 : CW_DONE + 64 * (l * 16 + 1)); }
            bg_tail(F, l * 16 + 1, false, S.slack(), 1, l >> 1);
        }
        GRID_BAR();
        { const Frame F = relaunder(F0);
            OpsDense O{2048, 2048, 2048, (const char*)(ws + WS_MB), (const char*)(ws + WS_WOUT + (size_t)l * 1024 * 1024 * 2), 0};
            pg8::DenseOrder S; S.init(nM, 4, F.G, bid);
            EpiStore E{(bf16*)(ws + WS_MO), D};
            RPT(14) { if (rep_) GRID_BAR(); PH(14) pg8::gemm_phase<0>(F.lds, F.wave, O, S, E, S.slack() ? -1 : CW_DONE + 64 * (l * 16 + 2)); }
            bg_tail(F, l * 16 + 2, false, S.slack(), 1, l >> 1);
        }
        GRID_BAR();
        RPT(15) { if (rep_) GRID_BAR(); PH(15) { const Frame F = relaunder(F0); const bool shadow = (NREP(15) == 2) && rep_ == 0;
            NpArgs P{}; P.xin_lat = (l == 0) ? (const void*)INP(I_X) : (const void*)OUTP(); P.xin_ctx = (l == 0) ? (const void*)INP(I_CTX) : (const void*)XC;
            P.xout_lat = last ? (void*)(ws + WS_XPARK) : (void*)OUTP(); P.xout_ctx = XC;
            P.ysrc = (const bf16*)(ws + WS_MO); P.gate = shadow ? (const float*)(ws + WS_ZERO) : (modb + (size_t)l * 9 * 6144); P.gate_off = 2048; P.gA = INP(I_NORMG) + (l * 4 + 1) * D;
            P.gB = INP(I_NORMG) + (l * 4 + 2) * D; P.modh = modb + (size_t)l * 9 * 6144; P.shift_off = 3072; P.scale_off = 4096; P.hout = HB; P.nrows = last ? TL : TT;
            if (l & 1) { P.wrouter = INP(I_WROUTER) + (size_t)(l >> 1) * D * 8; P.brouter = INP(I_BROUTER) + (l >> 1) * 8; P.cursor = (unsigned*)(CTLP() + CW_CURSOR + ((l >> 1) + (shadow ? 2 : 0)) * 8 * 64);
                P.tokrec = ws + WS_TOKREC; P.slottok = (int*)(ws + WS_SLOTTOK); if (f8) norm_pass<1, true, true, 1, true, true>(F, P); else norm_pass<1, true, true, 0, true, true>(F, P); }
            else { if (l == 0) norm_pass<1, true, false, 0, false, true>(F, P); else if (f8) norm_pass<1, true, false, 1, true, true>(F, P); else norm_pass<1, true, false, 0, true, true>(F, P); }
        } }
        GRID_BAR();
        if ((l & 1) == 0) {
            const int j = l >> 1;
            { const Frame F = relaunder(F0);
                pg8::DenseOrder S; S.init(nM, 22, F.G, bid);
                const char* W1p = (const char*)(ws + WS_FFN1 + (size_t)j * 2 * DFF * D * 2);
                if (f8) { OpsDense O{D, D, D, (const char*)HB, W1p, 0}; EpiSwiglu<true> E{ws + WS_HID, DFF, 0};
                    RPT(16) { if (rep_) GRID_BAR(); PH(16) pg8::gemm_phase<124>(F.lds, F.wave, O, S, E, S.slack() ? -1 : CW_DONE + 64 * (l * 16 + 3)); } }
                else { OpsDense O{2 * D, 2 * D, 2 * D, (const char*)HB, W1p, 0}; EpiSwiglu<false> E{ws + WS_HID, DFF, 0};
                    RPT(16) { if (rep_) GRID_BAR(); PH(16) pg8::gemm_phase<0>(F.lds, F.wave, O, S, E, S.slack() ? -1 : CW_DONE + 64 * (l * 16 + 3)); } }
                bg_tail(F, l * 16 + 3, false, S.slack(), 1, l >> 1);
            }
            GRID_BAR();
            { const Frame F = relaunder(F0);
                pg8::DenseOrder S; S.init(nM, 4, F.G, bid);
                const char* W2p = (const char*)(ws + WS_FFN2 + (size_t)j * D * DFF * 2);
                EpiStore E{(bf16*)(ws + WS_FY), D};
                if (f8) { OpsDense O{DFF, DFF, DFF, (const char*)(ws + WS_HID), W2p, 0};
                    RPT(17) { if (rep_) GRID_BAR(); PH(17) pg8::gemm_phase<124>(F.lds, F.wave, O, S, E, S.slack() ? -1 : CW_DONE + 64 * (l * 16 + 4)); } }
                else { OpsDense O{2 * DFF, 2 * DFF, 2 * DFF, (const char*)(ws + WS_HID), W2p, 0};
                    RPT(17) { if (rep_) GRID_BAR(); PH(17) pg8::gemm_phase<0>(F.lds, F.wave, O, S, E, S.slack() ? -1 : CW_DONE + 64 * (l * 16 + 4)); } }
                bg_tail(F, l * 16 + 4, false, S.slack(), 1, l >> 1);
            }
            GRID_BAR();
        } else {
            const int j = l >> 1;
            int ntiles;
            { const Frame F = relaunder(F0);
                const gu32* cursor = CTLP() + CW_CURSOR + j * 8 * 64;
                ntiles = moe_tables(F, cursor, tab_ebase, tab_tile);
                RPT(18) { if (rep_) GRID_BAR(); PH(18) moe_gather(F, tab_ebase, ntiles, (const int*)(ws + WS_SLOTTOK), HB, (bf16*)(ws + WS_ASORT), f8); }
                bg_work(F, j, j, 8, true);
            }
            GRID_BAR();
            const int npass = f8 ? 1 : 2, ptiles = f8 ? MOE_MAXTILES : MOE_PASS_TILES;
            for (int pass = 0; pass < npass; ++pass) {
                const int t0 = pass * ptiles, t1 = (t0 + ptiles) < ntiles ? (t0 + ptiles) : ntiles;
                { const Frame F = relaunder(F0);
                    pg8::MoeOrder S; S.init(t0, t1, 28, F.G, bid, tab_tile);
                    const char* W1p = (const char*)(ws + WS_EXP1 + (size_t)j * 8 * 2 * DFFE * D * 2);
                    if (f8) { OpsMoe O{D, D, D, (const char*)(ws + WS_ASORT), W1p, (size_t)2 * DFFE * D * 2, 0}; EpiSwiglu<true> E{ws + WS_HIDM, DFFE, t0};
                        RPT(19) { if (rep_) GRID_BAR(); PH(19) pg8::gemm_phase<124>(F.lds, F.wave, O, S, E, S.slack() ? -1 : CW_DONE + 64 * (l * 16 + 5 + 2 * pass)); } }
                    else { OpsMoe O{2 * D, 2 * D, 2 * D, (const char*)(ws + WS_ASORT), W1p, (size_t)2 * DFFE * D * 2, 0}; EpiSwiglu<false> E{ws + WS_HIDM, DFFE, t0};
                        RPT(19) { if (rep_) GRID_BAR(); PH(19) pg8::gemm_phase<0>(F.lds, F.wave, O, S, E, S.slack() ? -1 : CW_DONE + 64 * (l * 16 + 5 + 2 * pass)); } }
                    if (j == 0) bg_tail(F, l * 16 + 5 + 2 * pass, false, S.slack(), 1, 1);
                }
                GRID_BAR();
                { const Frame F = relaunder(F0);
                    pg8::MoeOrder S; S.init(t0, t1, 4, F.G, bid, tab_tile);
                    const char* W2p = (const char*)(ws + WS_EXP2 + (size_t)j * 8 * D * DFFE * 2);
                    EpiStore E{(bf16*)(ws + WS_YSLOT), D};
                    if (f8) { OpsMoe O{DFFE, DFFE, DFFE, (const char*)(ws + WS_HIDM) - (size_t)t0 * 256 * DFFE, W2p, (size_t)D * DFFE * 2, 0};
                        RPT(20) { if (rep_) GRID_BAR(); PH(20) pg8::gemm_phase<124>(F.lds, F.wave, O, S, E, S.slack() ? -1 : CW_DONE + 64 * (l * 16 + 6 + 2 * pass)); } }
                    else { OpsMoe O{2 * DFFE, 2 * DFFE, 2 * DFFE, (const char*)(ws + WS_HIDM) - (size_t)t0 * 256 * DFFE * 2, W2p, (size_t)D * DFFE * 2, 0};
                        RPT(20) { if (rep_) GRID_BAR(); PH(20) pg8::gemm_phase<0>(F.lds, F.wave, O, S, E, S.slack() ? -1 : CW_DONE + 64 * (l * 16 + 6 + 2 * pass)); } }
                    if (j == 0) bg_tail(F, l * 16 + 6 + 2 * pass, false, S.slack(), 1, 1);
                }
                GRID_BAR();
            }
        }
        RPT(21) { if (rep_) GRID_BAR(); PH(21) { const Frame F = relaunder(F0); const bool shadow = (NREP(21) == 2) && rep_ == 0;
            NpArgs P{}; P.xin_lat = last ? (const void*)(ws + WS_XPARK) : (const void*)OUTP(); P.xin_ctx = XC; P.xout_lat = OUTP(); P.xout_ctx = XC;
            P.gate = shadow ? (const float*)(ws + WS_ZERO) : (modb + (size_t)l * 9 * 6144); P.gate_off = 5120; P.gA = INP(I_NORMG) + (l * 4 + 3) * D; P.nrows = last ? TL : TT;
            if (!last) { P.gB = INP(I_NORMG) + ((l + 1) * 4 + 0) * D; P.modh = modb + (size_t)(l + 1) * 9 * 6144; P.shift_off = 0; P.scale_off = 1024; P.hout = HB; P.hout8 = ws + WS_H8; }
            if (l & 1) { P.ysrc = (const bf16*)(ws + WS_YSLOT); P.tokrec = ws + WS_TOKREC; P.ebase = tab_ebase;
                if (last) norm_pass<2, false, false, 0, true, false>(F, P); else norm_pass<2, true, false, 2, true, true>(F, P); }
            else { P.ysrc = (const bf16*)(ws + WS_FY); norm_pass<1, true, false, 2, true, true>(F, P); }
        } }
        if (!last) GRID_BAR();
    }
}

#undef ws
#undef modb
#undef HB
#undef XC
extern "C" void kernel_launch(void* const* d_in, const int* in_sizes, int n_in, void* d_out, int out_size, void* d_ws, size_t ws_size, hipStream_t stream) {
    static int grid = 0;
    if (grid == 0) {
        if (n_in != 30 || out_size != TL * D || ws_size < WS_END) { fprintf(stderr, "kernel_launch: unexpected shapes (n_in %d out %d ws %zu need %zu)\n", n_in, out_size, ws_size, (size_t)WS_END); grid = -1; return; }
        int dev = 0, cus = 0;
        if (hipGetDevice(&dev) != hipSuccess || hipDeviceGetAttribute(&cus, hipDeviceAttributeMultiprocessorCount, dev) != hipSuccess) { grid = -1; return; }
        if (hipFuncSetAttribute((const void*)hybrid_fwd, hipFuncAttributeMaxDynamicSharedMemorySize, LDS_BYTES) != hipSuccess) { fprintf(stderr, "kernel_launch: hipFuncSetAttribute failed\n"); grid = -1; return; }
        int per_cu = 0;
        if (hipOccupancyMaxActiveBlocksPerMultiprocessor(&per_cu, (const void*)hybrid_fwd, 512, LDS_BYTES) != hipSuccess || per_cu < 1) { fprintf(stderr, "kernel_launch: occupancy query says %d\n", per_cu); }
        (void)hipGetLastError();
        grid = cus;
    }
    if (grid < 0) return;
    if (hipMemsetAsync((char*)d_ws + WS_CTL, 0, CTL_ZERO_BYTES, stream) != hipSuccess) return;
    Args a{};
    for (int i = 0; i < 30; ++i) a.in[i] = (const float*)d_in[i];
    a.out = (float*)d_out; a.ws = (unsigned char*)d_ws;
    hipLaunchKernelGGL(hybrid_fwd, dim3(grid), dim3(512), LDS_BYTES, stream, a);
}
```
